# Optimizing an MI355X kernel written in HIP

```python
import math
import jax, jax.numpy as jnp
from jax import lax
import numpy as np

D_MODEL = 2048
BATCH = 4
SEQ = 2048
DEPTH = 1
DEC_BATCH = 8
DEC_SEQ = 4
PAST_LEN = 16384
PAGE_SIZE = 128

N_META = 16
ATT_WIDTH = D_MODEL // 2
HEAD_DIM_A = 64
V_DIM_A = 2 * HEAD_DIM_A
N_HEADS_A = ATT_WIDTH // V_DIM_A
MLSTM_WIDTH = D_MODEL - ATT_WIDTH
N_HEADS_M = 4
HEAD_DIM_M = MLSTM_WIDTH // N_HEADS_M
CONV_W = 4
CHUNK = 64
Q_BLOCK = 128
D_FF = 4 * D_MODEL
PROJ_WIDTH = 3 * ATT_WIDTH + 3 * MLSTM_WIDTH + 2 * N_HEADS_M
FORGET_BIAS = 3.0
EPS = 1e-6

kernel_name = "hymba_diffattn_mlstm_decoder_step"


def rms_norm(x, g):
    xf = x.astype(jnp.float32)
    y = xf * lax.rsqrt(jnp.mean(xf * xf, axis=-1, keepdims=True) + EPS)
    return (y * g.astype(jnp.float32)).astype(x.dtype)


def alibi_slopes():
    return 2.0 ** (-8.0 * jnp.arange(1, N_HEADS_A + 1, dtype=jnp.float32) / N_HEADS_A)


def diff_lambda(lambda_qk, lam_init):
    l = lambda_qk.astype(jnp.float32)
    return jnp.exp(jnp.sum(l[0] * l[1])) - jnp.exp(jnp.sum(l[2] * l[3])) + lam_init


def mixer_projections(x, norm_g, w_in, q_g, k_g):
    B, T, _ = x.shape
    z = rms_norm(x, norm_g) @ w_in
    widths = [ATT_WIDTH] * 3 + [MLSTM_WIDTH] * 3 + [N_HEADS_M]
    offs = []
    acc = 0
    for w in widths:
        acc += w
        offs.append(acc)
    qa, ka, va, u, vm, og, gi, gf = jnp.split(z, offs, axis=-1)
    qa = rms_norm(qa.reshape(B, T, N_HEADS_A, 2, HEAD_DIM_A), q_g)
    ka = rms_norm(ka.reshape(B, T, N_HEADS_A, 2, HEAD_DIM_A), k_g)
    va = va.reshape(B, T, N_HEADS_A, V_DIM_A)
    return qa, ka, va, u, vm, og, gi, gf


def diff_attend(q, k, v, q_pos, k_pos, lam, slopes):
    s = jnp.einsum("bqhmd,bkhmd->bhmqk", q, k, preferred_element_type=jnp.float32) * (HEAD_DIM_A ** -0.5)
    dist = q_pos[:, None] - k_pos[None, :]
    bias = -slopes[:, None, None] * dist.astype(jnp.float32)[None]
    s = jnp.where((dist >= 0)[None, None, None], s + bias[None, :, None], -jnp.inf)
    p = jax.nn.softmax(s, axis=-1)
    a = p[:, :, 0] - lam * p[:, :, 1]
    return jnp.einsum("bhqk,bkhd->bqhd", a.astype(v.dtype), v)


def prompt_attention(qa, ka, va, lam, slopes):
    B, T = qa.shape[:2]
    pos = jnp.arange(T)
    out_meta = diff_attend(qa[:, :N_META], ka[:, :N_META], va[:, :N_META], pos[:N_META], pos[:N_META], lam, slopes)
    n_blk = (T - N_META) // Q_BLOCK
    q_blocks = jnp.moveaxis(qa[:, N_META:].reshape(B, n_blk, Q_BLOCK, N_HEADS_A, 2, HEAD_DIM_A), 1, 0)
    p_blocks = pos[N_META:].reshape(n_blk, Q_BLOCK)
    out_blocks = lax.map(lambda qp: diff_attend(qp[0], ka, va, qp[1], pos, lam, slopes), (q_blocks, p_blocks))
    out_real = jnp.moveaxis(out_blocks, 0, 1).reshape(B, T - N_META, N_HEADS_A, V_DIM_A)
    return jnp.concatenate([out_meta, out_real], axis=1)


def mlstm_features(u, vm, gi, gf, conv_buf, conv_w, conv_b, w_qm, w_km, gate_bias):
    B, T, _ = u.shape
    up = jnp.concatenate([conv_buf.astype(u.dtype), u], axis=1)
    conv = conv_b
    for j in range(CONV_W):
        conv = conv + up[:, j:j + T] * conv_w[j]
    ua = jax.nn.silu(conv).reshape(B, T, N_HEADS_M, HEAD_DIM_M)
    q = jnp.einsum("bthd,hde->bthe", ua, w_qm).astype(jnp.float32)
    k = (jnp.einsum("bthd,hde->bthe", ua, w_km) * HEAD_DIM_M ** -0.5).astype(jnp.float32)
    v = vm.reshape(B, T, N_HEADS_M, HEAD_DIM_M).astype(jnp.float32)
    ig = (gi + gate_bias[0]).astype(jnp.float32)
    lf = jax.nn.log_sigmoid((gf + gate_bias[1]).astype(jnp.float32))
    return (q, k, v, ig, lf), up[:, -(CONV_W - 1):]


def mlstm_chunk(state, feats):
    C0, n0, m0 = state
    q, k, v, ig, lf = feats
    L = q.shape[1]
    b = jnp.moveaxis(jnp.cumsum(lf, axis=1), 1, -1)
    i_ = jnp.moveaxis(ig, 1, -1)
    causal = jnp.tril(jnp.ones((L, L), dtype=bool))
    d = jnp.where(causal, b[..., :, None] - b[..., None, :] + i_[..., None, :], -jnp.inf)
    inter = b + m0[..., None]
    m = jnp.maximum(inter, jnp.max(d, axis=-1))
    w_inter = jnp.exp(inter - m)
    s = jnp.einsum("bthd,bshd->bhts", q, k) * jnp.exp(d - m[..., None])
    num = w_inter[..., None] * jnp.einsum("bthd,bhde->bhte", q, C0) + jnp.einsum("bhts,bshe->bhte", s, v)
    den = w_inter * jnp.einsum("bthd,bhd->bht", q, n0) + jnp.sum(s, axis=-1)
    h = num / jnp.maximum(jnp.abs(den), jnp.exp(-m))[..., None]
    m_end = m[..., -1]
    w_c = jnp.exp(b[..., -1] + m0 - m_end)
    w_s = jnp.exp(b[..., -1:] - b + i_ - m_end[..., None])
    C = w_c[..., None, None] * C0 + jnp.einsum("bhs,bshd,bshe->bhde", w_s, k, v)
    n = w_c[..., None] * n0 + jnp.einsum("bhs,bshd->bhd", w_s, k)
    return (C, n, m_end), jnp.moveaxis(h, 1, 2)


def prompt_mlstm(feats):
    q = feats[0]
    B = q.shape[0]
    state = (jnp.zeros((B, N_HEADS_M, HEAD_DIM_M, HEAD_DIM_M), jnp.float32),
             jnp.zeros((B, N_HEADS_M, HEAD_DIM_M), jnp.float32),
             jnp.zeros((B, N_HEADS_M), jnp.float32))
    state, h_meta = mlstm_chunk(state, tuple(a[:, :N_META] for a in feats))
    def to_chunks(a):
        r = a[:, N_META:]
        nc = r.shape[1] // CHUNK
        return jnp.moveaxis(r.reshape(B, nc, CHUNK, *r.shape[2:]), 1, 0)
    state, h_chunks = lax.scan(mlstm_chunk, state, tuple(to_chunks(a) for a in feats))
    h_real = jnp.moveaxis(h_chunks, 0, 1).reshape(B, -1, N_HEADS_M, HEAD_DIM_M)
    return jnp.concatenate([h_meta, h_real], axis=1), state


def mlstm_output(h, og, g):
    B, T = h.shape[:2]
    hn = rms_norm(h, g)
    o = jax.nn.sigmoid(og.astype(jnp.float32)).reshape(B, T, N_HEADS_M, HEAD_DIM_M)
    return (hn * o).reshape(B, T, MLSTM_WIDTH).astype(og.dtype)


def finish_layer(x, a_heads, m_out, lam_init, attn_out_norm, w_out, norm_ffn, w_up, w_down):
    B, T, _ = x.shape
    a = (rms_norm(a_heads, attn_out_norm) * (1.0 - lam_init)).reshape(B, T, ATT_WIDTH)
    x = x + jnp.concatenate([a.astype(x.dtype), m_out.astype(x.dtype)], axis=-1) @ w_out
    hf = rms_norm(x, norm_ffn) @ w_up
    return x + jnp.square(jax.nn.relu(hf)) @ w_down


def setup_inputs(seed: int = 0) -> dict:
    key = jax.random.key(seed)
    ks = jax.random.split(key, 28)
    n_pages = PAST_LEN // PAGE_SIZE
    n_pool = (DEC_BATCH * n_pages * 5) // 4
    def nrm(k, shape, scale=1.0):
        return jax.random.normal(k, shape, jnp.float32) * scale
    perm = jax.random.permutation(ks[8], n_pool)
    page_table = perm[: DEC_BATCH * n_pages].reshape(DEC_BATCH, n_pages).astype(jnp.int32)
    return {
        "x_prompt": nrm(ks[0], (BATCH, SEQ, D_MODEL)),
        "x_sample": nrm(ks[1], (DEC_BATCH, DEC_SEQ, D_MODEL)),
        "cache_k": nrm(ks[2], (DEPTH, n_pool, PAGE_SIZE, N_HEADS_A, 2 * HEAD_DIM_A)),
        "cache_v": nrm(ks[3], (DEPTH, n_pool, PAGE_SIZE, N_HEADS_A, V_DIM_A)),
        "state_C": nrm(ks[4], (DEPTH, DEC_BATCH, N_HEADS_M, HEAD_DIM_M, HEAD_DIM_M), 0.5),
        "state_n": nrm(ks[5], (DEPTH, DEC_BATCH, N_HEADS_M, HEAD_DIM_M), 0.5),
        "state_m": 1.0 + nrm(ks[6], (DEPTH, DEC_BATCH, N_HEADS_M), 0.5),
        "state_conv": nrm(ks[7], (DEPTH, DEC_BATCH, CONV_W - 1, MLSTM_WIDTH)),
        "page_table": page_table,
        "meta_tokens": nrm(ks[9], (N_META, D_MODEL)),
        "norm_mix": 1.0 + nrm(ks[10], (DEPTH, D_MODEL), 0.02),
        "w_in": nrm(ks[11], (DEPTH, D_MODEL, PROJ_WIDTH), D_MODEL ** -0.5),
        "q_norm": 1.0 + nrm(ks[12], (DEPTH, HEAD_DIM_A), 0.02),
        "k_norm": 1.0 + nrm(ks[13], (DEPTH, HEAD_DIM_A), 0.02),
        "lambda_qk": nrm(ks[14], (DEPTH, 4, HEAD_DIM_A), 0.1),
        "attn_out_norm": 1.0 + nrm(ks[15], (DEPTH, V_DIM_A), 0.02),
        "conv_w": nrm(ks[16], (DEPTH, CONV_W, MLSTM_WIDTH), CONV_W ** -0.5),
        "conv_b": nrm(ks[17], (DEPTH, MLSTM_WIDTH), 0.02),
        "w_qm": nrm(ks[18], (DEPTH, N_HEADS_M, HEAD_DIM_M, HEAD_DIM_M), HEAD_DIM_M ** -0.5),
        "w_km": nrm(ks[19], (DEPTH, N_HEADS_M, HEAD_DIM_M, HEAD_DIM_M), HEAD_DIM_M ** -0.5),
        "gate_bias": jnp.stack([nrm(ks[20], (DEPTH, N_HEADS_M), 0.1),
                                FORGET_BIAS + nrm(ks[21], (DEPTH, N_HEADS_M), 0.1)], axis=1),
        "mlstm_out_norm": 1.0 + nrm(ks[22], (DEPTH, HEAD_DIM_M), 0.02),
        "w_out": nrm(ks[23], (DEPTH, D_MODEL, D_MODEL), D_MODEL ** -0.5),
        "norm_ffn": 1.0 + nrm(ks[24], (DEPTH, D_MODEL), 0.02),
        "w_up": nrm(ks[25], (DEPTH, D_MODEL, D_FF), D_MODEL ** -0.5),
        "w_down": nrm(ks[26], (DEPTH, D_FF, D_MODEL), D_FF ** -0.5),
    }


def reference(x_prompt, x_sample, cache_k, cache_v, state_C, state_n, state_m, state_conv, page_table,
              meta_tokens, norm_mix, w_in, q_norm, k_norm, lambda_qk, attn_out_norm, conv_w, conv_b,
              w_qm, w_km, gate_bias, mlstm_out_norm, w_out, norm_ffn, w_up, w_down):
    slopes = alibi_slopes()
    B, S, _ = x_prompt.shape
    Bd, Ts, _ = x_sample.shape
    past_len = page_table.shape[1] * PAGE_SIZE
    T = S + N_META
    xp = jnp.concatenate([jnp.broadcast_to(meta_tokens.astype(x_prompt.dtype)[None], (B, N_META, D_MODEL)), x_prompt], axis=1)
    xs = x_sample
    pos_q_s = past_len + jnp.arange(Ts)
    pos_k_s = jnp.arange(past_len + Ts)
    kp, vp, Cp, np_, mp, cp = [], [], [], [], [], []
    ksl, vsl, Csl, nsl, msl, csl = [], [], [], [], [], []
    for l in range(DEPTH):
        lam_init = 0.8 - 0.6 * math.exp(-0.3 * l)
        lam = diff_lambda(lambda_qk[l], lam_init)
        qa, ka, va, u, vm, og, gi, gf = mixer_projections(xp, norm_mix[l], w_in[l], q_norm[l], k_norm[l])
        a_p = prompt_attention(qa, ka, va, lam, slopes)
        feats, conv_p = mlstm_features(u, vm, gi, gf, jnp.zeros((B, CONV_W - 1, MLSTM_WIDTH), u.dtype),
                                       conv_w[l], conv_b[l], w_qm[l], w_km[l], gate_bias[l])
        h_p, (C_p, n_p, m_p) = prompt_mlstm(feats)
        xp = finish_layer(xp, a_p, mlstm_output(h_p, og, mlstm_out_norm[l]), lam_init,
                          attn_out_norm[l], w_out[l], norm_ffn[l], w_up[l], w_down[l])
        kp.append(ka.reshape(B, T, N_HEADS_A, 2 * HEAD_DIM_A))
        vp.append(va)
        Cp.append(C_p)
        np_.append(n_p)
        mp.append(m_p)
        cp.append(conv_p)
        qs, kss, vs, us, vms, ogs, gis, gfs = mixer_projections(xs, norm_mix[l], w_in[l], q_norm[l], k_norm[l])
        past_k = cache_k[l, page_table].reshape(Bd, past_len, N_HEADS_A, 2, HEAD_DIM_A)
        past_v = cache_v[l, page_table].reshape(Bd, past_len, N_HEADS_A, V_DIM_A)
        k_all = jnp.concatenate([past_k.astype(kss.dtype), kss], axis=1)
        v_all = jnp.concatenate([past_v.astype(vs.dtype), vs], axis=1)
        a_s = diff_attend(qs, k_all, v_all, pos_q_s, pos_k_s, lam, slopes)
        feats_s, conv_s = mlstm_features(us, vms, gis, gfs, state_conv[l], conv_w[l], conv_b[l],
                                         w_qm[l], w_km[l], gate_bias[l])
        st = (state_C[l].astype(jnp.float32), state_n[l].astype(jnp.float32), state_m[l].astype(jnp.float32))
        (C_s, n_s, m_s), h_s = mlstm_chunk(st, feats_s)
        xs = finish_layer(xs, a_s, mlstm_output(h_s, ogs, mlstm_out_norm[l]), lam_init,
                          attn_out_norm[l], w_out[l], norm_ffn[l], w_up[l], w_down[l])
        ksl.append(kss.reshape(Bd, Ts, N_HEADS_A, 2 * HEAD_DIM_A))
        vsl.append(vs)
        Csl.append(C_s)
        nsl.append(n_s)
        msl.append(m_s)
        csl.append(conv_s)
    y_prompt = xp[:, N_META:]
    y_sample = xs
    return (y_prompt, y_sample,
            jnp.stack(kp), jnp.stack(vp), jnp.stack(Cp), jnp.stack(np_), jnp.stack(mp), jnp.stack(cp),
            jnp.stack(ksl), jnp.stack(vsl), jnp.stack(Csl), jnp.stack(nsl), jnp.stack(msl), jnp.stack(csl))
```

```cpp
#include <hip/hip_runtime.h>
#include <math.h>
#include <stdint.h>
#ifdef HOST_SIM
#define HD static inline
#define HDH static inline
#else
#define HD __device__ __forceinline__
#define HDH __host__ __device__ __forceinline__
#endif

namespace cfg {
#ifdef SMALL_CFG
constexpr int D_MODEL = 128, BATCH = 2, SEQ = 256, DEC_BATCH = 2, DEC_SEQ = 4, PAST_LEN = 256, PAGE_SIZE = 32, N_META = 16, HEAD_DIM_A = 16, N_HEADS_M = 2;
#else
constexpr int D_MODEL = 2048, BATCH = 4, SEQ = 2048, DEC_BATCH = 8, DEC_SEQ = 4, PAST_LEN = 16384, PAGE_SIZE = 128, N_META = 16, HEAD_DIM_A = 64, N_HEADS_M = 4;
#endif
constexpr int ATT_WIDTH = D_MODEL / 2, V_DIM_A = 2 * HEAD_DIM_A, N_HEADS_A = ATT_WIDTH / V_DIM_A;
constexpr int MLSTM_WIDTH = D_MODEL - ATT_WIDTH, HEAD_DIM_M = MLSTM_WIDTH / N_HEADS_M, CONV_W = 4, D_FF = 4 * D_MODEL;
constexpr int PROJ_WIDTH = 3 * ATT_WIDTH + 3 * MLSTM_WIDTH + 2 * N_HEADS_M;
constexpr int T = SEQ + N_META;
constexpr int N_PAGES = PAST_LEN / PAGE_SIZE;
constexpr int TK_S = PAST_LEN + DEC_SEQ;
constexpr float EPS = 1e-6f;
constexpr float LAM_INIT = 0.2f;
constexpr int R_PROMPT = BATCH * SEQ, R_SAMPLE = DEC_BATCH * DEC_SEQ, R_FULL = R_PROMPT + R_SAMPLE, R_ALL = R_FULL + N_META;
constexpr int ZQ = 0, ZK = ATT_WIDTH, ZV = 2 * ATT_WIDTH, ZU = 3 * ATT_WIDTH, ZVM = ZU + MLSTM_WIDTH, ZOG = ZVM + MLSTM_WIDTH, ZGI = ZOG + MLSTM_WIDTH, ZGF = ZGI + N_HEADS_M;
constexpr size_t O_Y = 0, O_YS = O_Y + (size_t)BATCH * SEQ * D_MODEL, O_KP = O_YS + (size_t)R_SAMPLE * D_MODEL,
    O_VP = O_KP + (size_t)BATCH * T * ATT_WIDTH, O_CP = O_VP + (size_t)BATCH * T * ATT_WIDTH,
    O_NP = O_CP + (size_t)BATCH * N_HEADS_M * HEAD_DIM_M * HEAD_DIM_M, O_MP = O_NP + (size_t)BATCH * N_HEADS_M * HEAD_DIM_M,
    O_CVP = O_MP + (size_t)BATCH * N_HEADS_M, O_KS = O_CVP + (size_t)BATCH * 3 * MLSTM_WIDTH, O_VS = O_KS + (size_t)R_SAMPLE * ATT_WIDTH,
    O_CS = O_VS + (size_t)R_SAMPLE * ATT_WIDTH, O_NS = O_CS + (size_t)DEC_BATCH * N_HEADS_M * HEAD_DIM_M * HEAD_DIM_M,
    O_MS = O_NS + (size_t)DEC_BATCH * N_HEADS_M * HEAD_DIM_M, O_CVS = O_MS + (size_t)DEC_BATCH * N_HEADS_M, O_END = O_CVS + (size_t)DEC_BATCH * 3 * MLSTM_WIDTH;
}

namespace nv {
using namespace cfg;
HD int prow(int b, int t) { return t < N_META ? R_FULL + t : b * SEQ + (t - N_META); }
HD float sigmoidf_(float x) { return 1.f / (1.f + expf(-x)); }
HD float logsigmoidf_(float x) { return x >= 0.f ? -log1pf(expf(-x)) : x - log1pf(expf(x)); }

struct P {
    const float *x_prompt, *x_sample, *cache_k, *cache_v, *state_C, *state_n, *state_m, *state_conv; const int* page_table;
    const float *meta, *norm_mix, *w_in, *q_norm, *k_norm, *lambda_qk, *attn_out_norm, *conv_w, *conv_b, *w_qm, *w_km, *gate_bias, *mlstm_out_norm, *w_out, *norm_ffn, *w_up, *w_down;
    float* out;
    float *XN;
    float *Z;
    float *Qn, *Kn;
    float *UA;
    float *MQ, *MK;
    float *Bc, *Mt;
    float *S;
    float *RS;
    float *Hm;
    float *Aa;
    float *AO;
    float *X1;
    float *XN2;
    float *Hf;
    float *SS;
};

HD const float* xrow(const P& p, int r) { return r < R_PROMPT ? p.x_prompt + (size_t)r * D_MODEL : r < R_FULL ? p.x_sample + (size_t)(r - R_PROMPT) * D_MODEL : p.meta + (size_t)(r - R_FULL) * D_MODEL; }
HD void k_rms_in(int gid, const P& p) {
    const float* x = xrow(p, gid); float s = 0.f;
    for (int i = 0; i < D_MODEL; ++i) s += x[i] * x[i];
    const float r = 1.f / sqrtf(s / D_MODEL + EPS);
    for (int i = 0; i < D_MODEL; ++i) p.XN[(size_t)gid * D_MODEL + i] = x[i] * r * p.norm_mix[i];
}
struct G { const float* A; const float* B; float* C; const float* R; int lda, ldb, ldc, ldr, M, N, K, act; float alpha; int pad; };
HDH G mkG(const float* A, int lda, const float* B, int ldb, float* C, int ldc, const float* R, int ldr, int M, int N, int K, float alpha, int act) { G g; g.A = A; g.B = B; g.C = C; g.R = R; g.lda = lda; g.ldb = ldb; g.ldc = ldc; g.ldr = ldr; g.M = M; g.N = N; g.K = K; g.act = act; g.alpha = alpha; g.pad = 0; return g; }
HDH int gemm_threads(const G& g) { return ((g.M + 3) / 4) * (g.N / 4); }
HD void k_gemm(int gid, const G& g) {
    const int nq = g.N / 4, mi = gid / nq, nj = gid % nq, m0 = mi * 4, n0 = nj * 4;
    float a00 = 0, a01 = 0, a02 = 0, a03 = 0, a10 = 0, a11 = 0, a12 = 0, a13 = 0, a20 = 0, a21 = 0, a22 = 0, a23 = 0, a30 = 0, a31 = 0, a32 = 0, a33 = 0;
    const int r1 = m0 + 1 < g.M ? m0 + 1 : m0, r2 = m0 + 2 < g.M ? m0 + 2 : m0, r3 = m0 + 3 < g.M ? m0 + 3 : m0;
    const float *A0 = g.A + (size_t)m0 * g.lda, *A1 = g.A + (size_t)r1 * g.lda, *A2 = g.A + (size_t)r2 * g.lda, *A3 = g.A + (size_t)r3 * g.lda;
    for (int k = 0; k < g.K; ++k) {
        const float* b = g.B + (size_t)k * g.ldb + n0; const float b0 = b[0], b1 = b[1], b2 = b[2], b3 = b[3];
        const float x0 = A0[k], x1 = A1[k], x2 = A2[k], x3 = A3[k];
        a00 += x0 * b0; a01 += x0 * b1; a02 += x0 * b2; a03 += x0 * b3;
        a10 += x1 * b0; a11 += x1 * b1; a12 += x1 * b2; a13 += x1 * b3;
        a20 += x2 * b0; a21 += x2 * b1; a22 += x2 * b2; a23 += x2 * b3;
        a30 += x3 * b0; a31 += x3 * b1; a32 += x3 * b2; a33 += x3 * b3;
    }
    const float acc[4][4] = {{a00, a01, a02, a03}, {a10, a11, a12, a13}, {a20, a21, a22, a23}, {a30, a31, a32, a33}};
#pragma unroll
    for (int i = 0; i < 4; ++i) { const int m = m0 + i; if (m < g.M) {
#pragma unroll
        for (int j = 0; j < 4; ++j) { float v = acc[i][j] * g.alpha; if (g.act == 1) { v = v > 0.f ? v * v : 0.f; }
            if (g.R) v += g.R[(size_t)m * g.ldr + n0 + j]; g.C[(size_t)m * g.ldc + n0 + j] = v; } } }
}
HD void k_qknorm(int gid, const P& p) {
    const int NG = 2 * N_HEADS_A, r = gid / (2 * NG), g2 = gid % (2 * NG), isk = g2 / NG, g = g2 % NG;
    const float* z = p.Z + (size_t)r * PROJ_WIDTH + (isk ? ZK : ZQ) + g * HEAD_DIM_A; float s = 0.f;
    for (int d = 0; d < HEAD_DIM_A; ++d) s += z[d] * z[d];
    const float rr = 1.f / sqrtf(s / HEAD_DIM_A + EPS); const float* gn = isk ? p.k_norm : p.q_norm;
    float* dst = (isk ? p.Kn : p.Qn) + (size_t)r * ATT_WIDTH + g * HEAD_DIM_A;
    for (int d = 0; d < HEAD_DIM_A; ++d) { const float v = z[d] * rr * gn[d]; dst[d] = v;
        if (isk) {
            if (r < R_PROMPT) { const int b = r / SEQ, s_ = r % SEQ; p.out[O_KP + ((size_t)(b * T + N_META + s_)) * ATT_WIDTH + g * HEAD_DIM_A + d] = v; }
            else if (r < R_FULL) p.out[O_KS + (size_t)(r - R_PROMPT) * ATT_WIDTH + g * HEAD_DIM_A + d] = v;
            else { for (int b = 0; b < BATCH; ++b) p.out[O_KP + ((size_t)(b * T + (r - R_FULL))) * ATT_WIDTH + g * HEAD_DIM_A + d] = v; }
        } }
}
HD void k_vout(int gid, const P& p) {
    const int r = gid / ATT_WIDTH, c = gid % ATT_WIDTH; const float v = p.Z[(size_t)r * PROJ_WIDTH + ZV + c];
    if (r < R_PROMPT) { const int b = r / SEQ, s_ = r % SEQ; p.out[O_VP + ((size_t)(b * T + N_META + s_)) * ATT_WIDTH + c] = v; }
    else if (r < R_FULL) p.out[O_VS + (size_t)(r - R_PROMPT) * ATT_WIDTH + c] = v;
    else { for (int b = 0; b < BATCH; ++b) p.out[O_VP + ((size_t)(b * T + (r - R_FULL))) * ATT_WIDTH + c] = v; }
}
HD float u_at(const P& p, int r, int c) { return p.Z[(size_t)r * PROJ_WIDTH + ZU + c]; }
HD void k_conv(int gid, const P& p) {
    const int r = gid / MLSTM_WIDTH, c = gid % MLSTM_WIDTH; float acc = p.conv_b[c];
    if (r < R_PROMPT || r >= R_FULL) {
        const int b = r < R_PROMPT ? r / SEQ : 0, t = r < R_PROMPT ? N_META + r % SEQ : r - R_FULL;
        for (int j = 0; j < CONV_W; ++j) { const int tt = t - (CONV_W - 1) + j; if (tt >= 0) acc += u_at(p, prow(b, tt), c) * p.conv_w[j * MLSTM_WIDTH + c]; }
        if (r < R_PROMPT) { const int s_ = r % SEQ; if (s_ >= SEQ - 3) p.out[O_CVP + ((size_t)(b * 3 + (s_ - (SEQ - 3)))) * MLSTM_WIDTH + c] = u_at(p, r, c); }
    } else {
        const int rs = r - R_PROMPT, bd = rs / DEC_SEQ, ts = rs % DEC_SEQ;
        for (int j = 0; j < CONV_W; ++j) { const int tt = ts - (CONV_W - 1) + j;
            const float uv = tt >= 0 ? u_at(p, R_PROMPT + bd * DEC_SEQ + tt, c) : p.state_conv[((size_t)bd * 3 + (tt + 3)) * MLSTM_WIDTH + c];
            acc += uv * p.conv_w[j * MLSTM_WIDTH + c]; }
        const int pos = 3 + ts;
        const int o = pos - (DEC_SEQ + 3 - 3); if (o >= 0) p.out[O_CVS + ((size_t)bd * 3 + o) * MLSTM_WIDTH + c] = u_at(p, r, c);
        if (DEC_SEQ < 3 && ts == 0) { for (int o2 = 0; o2 < 3 - DEC_SEQ; ++o2) p.out[O_CVS + ((size_t)bd * 3 + o2) * MLSTM_WIDTH + c] = p.state_conv[((size_t)bd * 3 + o2 + DEC_SEQ) * MLSTM_WIDTH + c]; }
    }
    p.UA[(size_t)r * MLSTM_WIDTH + c] = acc * sigmoidf_(acc);
}
HD float gate_i(const P& p, int r, int h) { return p.Z[(size_t)r * PROJ_WIDTH + ZGI + h] + p.gate_bias[h]; }
HD float gate_lf(const P& p, int r, int h) { return logsigmoidf_(p.Z[(size_t)r * PROJ_WIDTH + ZGF + h] + p.gate_bias[N_HEADS_M + h]); }
HD void k_scan(int gid, const P& p) {
    const int b = gid / N_HEADS_M, h = gid % N_HEADS_M; float B = 0.f, m = 0.f;
    for (int t = 0; t < T; ++t) { const int r = prow(b, t); const float lf = gate_lf(p, r, h), ig = gate_i(p, r, h);
        B += lf; m = fmaxf(lf + m, ig); p.Bc[(size_t)gid * T + t] = B; p.Mt[(size_t)gid * T + t] = m; }
    p.out[O_MP + gid] = m;
}
HD void k_mscore(int gid, const P& p) {
    const int s = gid % T, t = (gid / T) % T, bh = gid / (T * T), b = bh / N_HEADS_M, h = bh % N_HEADS_M;
    float v = 0.f;
    if (s <= t) { const int rt = prow(b, t), rs = prow(b, s); const float* q = p.MQ + (size_t)rt * MLSTM_WIDTH + h * HEAD_DIM_M; const float* k = p.MK + (size_t)rs * MLSTM_WIDTH + h * HEAD_DIM_M;
        float d = 0.f; for (int i = 0; i < HEAD_DIM_M; ++i) d += q[i] * k[i];
        v = d * expf(p.Bc[(size_t)bh * T + t] - p.Bc[(size_t)bh * T + s] + gate_i(p, rs, h) - p.Mt[(size_t)bh * T + t]); }
    p.S[gid] = v;
}
HD void k_mh(int gid, const P& p) {
    const int e = gid % HEAD_DIM_M, t = (gid / HEAD_DIM_M) % T, bh = gid / (HEAD_DIM_M * T), b = bh / N_HEADS_M, h = bh % N_HEADS_M;
    const float* S = p.S + ((size_t)bh * T + t) * T; float den = 0.f, num = 0.f;
    for (int s = 0; s <= t; ++s) { den += S[s]; num += S[s] * p.Z[(size_t)prow(b, s) * PROJ_WIDTH + ZVM + h * HEAD_DIM_M + e]; }
    const float hv = num / fmaxf(fabsf(den), expf(-p.Mt[(size_t)bh * T + t]));
    if (t >= N_META || b == 0) p.Hm[(size_t)prow(b, t) * MLSTM_WIDTH + h * HEAD_DIM_M + e] = hv;
}
HD void k_mstate(int gid, const P& p) {
    const int e = gid % (HEAD_DIM_M + 1), d = (gid / (HEAD_DIM_M + 1)) % HEAD_DIM_M, bh = gid / ((HEAD_DIM_M + 1) * HEAD_DIM_M), b = bh / N_HEADS_M, h = bh % N_HEADS_M;
    const float BT = p.Bc[(size_t)bh * T + T - 1], mT = p.Mt[(size_t)bh * T + T - 1]; float acc = 0.f;
    for (int s = 0; s < T; ++s) { const int rs = prow(b, s); const float w = expf(BT - p.Bc[(size_t)bh * T + s] + gate_i(p, rs, h) - mT);
        const float kv = p.MK[(size_t)rs * MLSTM_WIDTH + h * HEAD_DIM_M + d];
        acc += w * kv * (e < HEAD_DIM_M ? p.Z[(size_t)rs * PROJ_WIDTH + ZVM + h * HEAD_DIM_M + e] : 1.f); }
    if (e < HEAD_DIM_M) p.out[O_CP + ((size_t)bh * HEAD_DIM_M + d) * HEAD_DIM_M + e] = acc; else p.out[O_NP + (size_t)bh * HEAD_DIM_M + d] = acc;
}
struct SG { float b[DEC_SEQ], i[DEC_SEQ], m[DEC_SEQ]; };
HD void sample_gates(const P& p, int bd, int h, float& m0, float (&bb)[DEC_SEQ], float (&ii)[DEC_SEQ], float (&mm)[DEC_SEQ]) {
    m0 = p.state_m[bd * N_HEADS_M + h]; float B = 0.f, m = m0;
#pragma unroll
    for (int t = 0; t < DEC_SEQ; ++t) { const int r = R_PROMPT + bd * DEC_SEQ + t; const float lf = gate_lf(p, r, h), ig = gate_i(p, r, h); B += lf; m = fmaxf(lf + m, ig); bb[t] = B; ii[t] = ig; mm[t] = m; }
}
HD void k_smh(int gid, const P& p) {
    const int e = gid % HEAD_DIM_M, t = (gid / HEAD_DIM_M) % DEC_SEQ, bh = gid / (HEAD_DIM_M * DEC_SEQ), bd = bh / N_HEADS_M, h = bh % N_HEADS_M;
    float m0, bb[DEC_SEQ], ii[DEC_SEQ], mm[DEC_SEQ]; sample_gates(p, bd, h, m0, bb, ii, mm);
    float bt = 0.f, mt = 0.f;
#pragma unroll
    for (int j = 0; j < DEC_SEQ; ++j) if (j == t) { bt = bb[j]; mt = mm[j]; }
    const int rt = R_PROMPT + bd * DEC_SEQ + t; const float* q = p.MQ + (size_t)rt * MLSTM_WIDTH + h * HEAD_DIM_M;
    const float w_inter = expf(bt + m0 - mt);
    const float* C0 = p.state_C + (size_t)bh * HEAD_DIM_M * HEAD_DIM_M; const float* n0 = p.state_n + (size_t)bh * HEAD_DIM_M;
    float qc = 0.f, qn = 0.f; for (int d = 0; d < HEAD_DIM_M; ++d) { qc += q[d] * C0[(size_t)d * HEAD_DIM_M + e]; qn += q[d] * n0[d]; }
    float num = w_inter * qc, den = w_inter * qn;
#pragma unroll
    for (int s = 0; s < DEC_SEQ; ++s) if (s <= t) { const int rs = R_PROMPT + bd * DEC_SEQ + s; const float* k = p.MK + (size_t)rs * MLSTM_WIDTH + h * HEAD_DIM_M;
        float d_ = 0.f; for (int d = 0; d < HEAD_DIM_M; ++d) d_ += q[d] * k[d];
        const float sv = d_ * expf(bt - bb[s] + ii[s] - mt); den += sv; num += sv * p.Z[(size_t)rs * PROJ_WIDTH + ZVM + h * HEAD_DIM_M + e]; }
    p.Hm[(size_t)rt * MLSTM_WIDTH + h * HEAD_DIM_M + e] = num / fmaxf(fabsf(den), expf(-mt));
}
HD void k_smstate(int gid, const P& p) {
    const int e = gid % (HEAD_DIM_M + 1), d = (gid / (HEAD_DIM_M + 1)) % HEAD_DIM_M, bh = gid / ((HEAD_DIM_M + 1) * HEAD_DIM_M), bd = bh / N_HEADS_M, h = bh % N_HEADS_M;
    float m0, bb[DEC_SEQ], ii[DEC_SEQ], mm[DEC_SEQ]; sample_gates(p, bd, h, m0, bb, ii, mm);
    const float bL = bb[DEC_SEQ - 1], mE = mm[DEC_SEQ - 1], w_c = expf(bL + m0 - mE);
    float acc = w_c * (e < HEAD_DIM_M ? p.state_C[((size_t)bh * HEAD_DIM_M + d) * HEAD_DIM_M + e] : p.state_n[(size_t)bh * HEAD_DIM_M + d]);
#pragma unroll
    for (int s = 0; s < DEC_SEQ; ++s) { const int rs = R_PROMPT + bd * DEC_SEQ + s; const float w = expf(bL - bb[s] + ii[s] - mE);
        acc += w * p.MK[(size_t)rs * MLSTM_WIDTH + h * HEAD_DIM_M + d] * (e < HEAD_DIM_M ? p.Z[(size_t)rs * PROJ_WIDTH + ZVM + h * HEAD_DIM_M + e] : 1.f); }
    if (e < HEAD_DIM_M) p.out[O_CS + ((size_t)bh * HEAD_DIM_M + d) * HEAD_DIM_M + e] = acc; else p.out[O_NS + (size_t)bh * HEAD_DIM_M + d] = acc;
    if (d == 0 && e == 0) p.out[O_MS + bh] = mE;
}
HD float slope_of(int h) { return exp2f(-8.0f * (float)(h + 1) / (float)N_HEADS_A); }
HD float lam_of(const P& p) { float a = 0.f, c = 0.f; for (int d = 0; d < HEAD_DIM_A; ++d) { a += p.lambda_qk[d] * p.lambda_qk[HEAD_DIM_A + d]; c += p.lambda_qk[2 * HEAD_DIM_A + d] * p.lambda_qk[3 * HEAD_DIM_A + d]; } return expf(a) - expf(c) + LAM_INIT; }
HD void k_ascore(int gid, const P& p, int b) {
    const int k = gid % T, q = (gid / T) % T, hm = gid / (T * T), h = hm / 2, m = hm % 2; float v = -INFINITY;
    if (k <= q) { const float* qq = p.Qn + (size_t)prow(b, q) * ATT_WIDTH + hm * HEAD_DIM_A; const float* kk = p.Kn + (size_t)prow(b, k) * ATT_WIDTH + hm * HEAD_DIM_A;
        float d = 0.f; for (int i = 0; i < HEAD_DIM_A; ++i) d += qq[i] * kk[i];
        v = d * (1.0f / sqrtf((float)HEAD_DIM_A)) - slope_of(h) * (float)(q - k); }
    p.S[gid] = v;
}
HD void k_astat(int gid, const P& p) {
    const int q = gid % T; const float* s = p.S + (size_t)gid * T; float mx = -INFINITY;
    for (int k = 0; k <= q; ++k) mx = fmaxf(mx, s[k]);
    float l = 0.f; for (int k = 0; k <= q; ++k) l += expf(s[k] - mx);
    p.RS[(size_t)gid * 2] = mx; p.RS[(size_t)gid * 2 + 1] = l;
}
HD void k_aout(int gid, const P& p, int b) {
    const int e = gid % V_DIM_A, q = (gid / V_DIM_A) % T, h = gid / (V_DIM_A * T); const float lam = lam_of(p);
    const size_t r0 = ((size_t)(h * 2 + 0) * T + q), r1 = ((size_t)(h * 2 + 1) * T + q);
    const float m0 = p.RS[r0 * 2], l0 = p.RS[r0 * 2 + 1], m1 = p.RS[r1 * 2], l1 = p.RS[r1 * 2 + 1]; float acc = 0.f;
    for (int k = 0; k <= q; ++k) { const float a = expf(p.S[r0 * T + k] - m0) / l0 - lam * expf(p.S[r1 * T + k] - m1) / l1;
        acc += a * p.Z[(size_t)prow(b, k) * PROJ_WIDTH + ZV + h * V_DIM_A + e]; }
    if (q >= N_META || b == 0) p.Aa[(size_t)prow(b, q) * ATT_WIDTH + h * V_DIM_A + e] = acc;
}
HD const float* skey(const P& p, int bd, int j, int h) { if (j < PAST_LEN) { const int pg = p.page_table[bd * N_PAGES + j / PAGE_SIZE]; return p.cache_k + (((size_t)pg * PAGE_SIZE + j % PAGE_SIZE) * N_HEADS_A + h) * V_DIM_A; } return p.Kn + (size_t)(R_PROMPT + bd * DEC_SEQ + (j - PAST_LEN)) * ATT_WIDTH + h * V_DIM_A; }
HD const float* sval(const P& p, int bd, int j, int h) { if (j < PAST_LEN) { const int pg = p.page_table[bd * N_PAGES + j / PAGE_SIZE]; return p.cache_v + (((size_t)pg * PAGE_SIZE + j % PAGE_SIZE) * N_HEADS_A + h) * V_DIM_A; } return p.Z + (size_t)(R_PROMPT + bd * DEC_SEQ + (j - PAST_LEN)) * PROJ_WIDTH + ZV + h * V_DIM_A; }
HD void k_sscore(int gid, const P& p) {
    const int j = gid % TK_S, q = (gid / TK_S) % DEC_SEQ, hm = (gid / (TK_S * DEC_SEQ)) % (2 * N_HEADS_A), bd = gid / (TK_S * DEC_SEQ * 2 * N_HEADS_A), h = hm / 2, m = hm % 2;
    float v = -INFINITY; const int qpos = PAST_LEN + q;
    if (j <= qpos) { const float* qq = p.Qn + (size_t)(R_PROMPT + bd * DEC_SEQ + q) * ATT_WIDTH + hm * HEAD_DIM_A; const float* kk = skey(p, bd, j, h) + m * HEAD_DIM_A;
        float d = 0.f; for (int i = 0; i < HEAD_DIM_A; ++i) d += qq[i] * kk[i];
        v = d * (1.0f / sqrtf((float)HEAD_DIM_A)) - slope_of(h) * (float)(qpos - j); }
    p.SS[gid] = v;
}
HD void k_sstat(int gid, const P& p) {
    const float* s = p.SS + (size_t)gid * TK_S; float mx = -INFINITY; for (int j = 0; j < TK_S; ++j) mx = fmaxf(mx, s[j]);
    float l = 0.f; for (int j = 0; j < TK_S; ++j) l += expf(s[j] - mx);
    p.RS[(size_t)gid * 2] = mx; p.RS[(size_t)gid * 2 + 1] = l;
}
HD void k_sout(int gid, const P& p) {
    const int e = gid % V_DIM_A, q = (gid / V_DIM_A) % DEC_SEQ, h = (gid / (V_DIM_A * DEC_SEQ)) % N_HEADS_A, bd = gid / (V_DIM_A * DEC_SEQ * N_HEADS_A); const float lam = lam_of(p);
    const size_t r0 = (((size_t)bd * N_HEADS_A + h) * 2 + 0) * DEC_SEQ + q, r1 = (((size_t)bd * N_HEADS_A + h) * 2 + 1) * DEC_SEQ + q;
    const float m0 = p.RS[r0 * 2], l0 = p.RS[r0 * 2 + 1], m1 = p.RS[r1 * 2], l1 = p.RS[r1 * 2 + 1]; float acc = 0.f;
    for (int j = 0; j < TK_S; ++j) { const float a = expf(p.SS[r0 * TK_S + j] - m0) / l0 - lam * expf(p.SS[r1 * TK_S + j] - m1) / l1; acc += a * sval(p, bd, j, h)[e]; }
    p.Aa[(size_t)(R_PROMPT + bd * DEC_SEQ + q) * ATT_WIDTH + h * V_DIM_A + e] = acc;
}
HD void k_mixout(int gid, const P& p) {
    const int NH = N_HEADS_A + N_HEADS_M, r = gid / NH, hh = gid % NH;
    if (hh < N_HEADS_A) { const float* a = p.Aa + (size_t)r * ATT_WIDTH + hh * V_DIM_A; float s = 0.f; for (int e = 0; e < V_DIM_A; ++e) s += a[e] * a[e];
        const float rr = 1.f / sqrtf(s / V_DIM_A + EPS); for (int e = 0; e < V_DIM_A; ++e) p.AO[(size_t)r * D_MODEL + hh * V_DIM_A + e] = a[e] * rr * p.attn_out_norm[e] * (1.0f - LAM_INIT); }
    else { const int h = hh - N_HEADS_A; const float* a = p.Hm + (size_t)r * MLSTM_WIDTH + h * HEAD_DIM_M; float s = 0.f; for (int e = 0; e < HEAD_DIM_M; ++e) s += a[e] * a[e];
        const float rr = 1.f / sqrtf(s / HEAD_DIM_M + EPS);
        for (int e = 0; e < HEAD_DIM_M; ++e) p.AO[(size_t)r * D_MODEL + ATT_WIDTH + h * HEAD_DIM_M + e] = a[e] * rr * p.mlstm_out_norm[e] * sigmoidf_(p.Z[(size_t)r * PROJ_WIDTH + ZOG + h * HEAD_DIM_M + e]); }
}
HD void k_rms_ffn(int gid, const P& p) {
    const float* x = p.X1 + (size_t)gid * D_MODEL; float s = 0.f; for (int i = 0; i < D_MODEL; ++i) s += x[i] * x[i];
    const float r = 1.f / sqrtf(s / D_MODEL + EPS); for (int i = 0; i < D_MODEL; ++i) p.XN2[(size_t)gid * D_MODEL + i] = x[i] * r * p.norm_ffn[i];
}
}

#define NV_FN static
#define NV_STREAM_DECL , hipStream_t stream
#define NV_STREAM_USE , stream
namespace nv {
#define DEF_GK(fn) template <class... A> __global__ void __launch_bounds__(256) gk_##fn(int n, A... a) { for (int g = blockIdx.x * 256 + threadIdx.x; g < n; g += gridDim.x * 256) fn(g, a...); }
DEF_GK(k_rms_in) DEF_GK(k_gemm) DEF_GK(k_qknorm) DEF_GK(k_vout) DEF_GK(k_conv) DEF_GK(k_scan) DEF_GK(k_mscore) DEF_GK(k_mh) DEF_GK(k_mstate) DEF_GK(k_smh) DEF_GK(k_smstate)
DEF_GK(k_ascore) DEF_GK(k_astat) DEF_GK(k_aout) DEF_GK(k_sscore) DEF_GK(k_sstat) DEF_GK(k_sout) DEF_GK(k_mixout) DEF_GK(k_rms_ffn)
}
#define LAUNCH(fn, n, ...) do { const int n_ = (n); int blocks_ = (n_ + 255) / 256; if (blocks_ > 262144) blocks_ = 262144; hipLaunchKernelGGL(nv::gk_##fn, dim3(blocks_), dim3(256), 0, stream, n_, __VA_ARGS__); } while (0)
namespace nv {
struct WsMap { size_t XN, Z, Qn, Kn, UA, MQ, MK, Bc, Mt, S, RS, Hm, Aa, AO, X1, XN2, Hf, SS, END; };
inline WsMap ws_map() {
    WsMap w; size_t o = 0; auto take = [&](size_t n) { size_t r = o; o += (n + 63) / 64 * 64; return r; };
    w.XN = take((size_t)R_ALL * D_MODEL); w.Z = take((size_t)R_ALL * PROJ_WIDTH); w.Qn = take((size_t)R_ALL * ATT_WIDTH); w.Kn = take((size_t)R_ALL * ATT_WIDTH);
    w.UA = take((size_t)R_ALL * MLSTM_WIDTH); w.MQ = take((size_t)R_ALL * MLSTM_WIDTH); w.MK = take((size_t)R_ALL * MLSTM_WIDTH);
    w.Bc = take((size_t)BATCH * N_HEADS_M * T); w.Mt = take((size_t)BATCH * N_HEADS_M * T);
    const size_t s1 = (size_t)BATCH * N_HEADS_M * T * T, s2 = (size_t)N_HEADS_A * 2 * T * T; w.S = take(s1 > s2 ? s1 : s2);
    w.RS = take((size_t)2 * (N_HEADS_A * 2 * T > DEC_BATCH * N_HEADS_A * 2 * DEC_SEQ ? N_HEADS_A * 2 * T : DEC_BATCH * N_HEADS_A * 2 * DEC_SEQ));
    w.Hm = take((size_t)R_ALL * MLSTM_WIDTH); w.Aa = take((size_t)R_ALL * ATT_WIDTH); w.AO = take((size_t)R_FULL * D_MODEL); w.X1 = take((size_t)R_FULL * D_MODEL);
    w.XN2 = take((size_t)R_FULL * D_MODEL); w.Hf = take((size_t)R_FULL * D_FF); w.SS = take((size_t)DEC_BATCH * N_HEADS_A * 2 * DEC_SEQ * TK_S); w.END = o; return w;
}
inline void bind_ws(P& p, float* ws) { const WsMap w = ws_map(); p.XN = ws + w.XN; p.Z = ws + w.Z; p.Qn = ws + w.Qn; p.Kn = ws + w.Kn; p.UA = ws + w.UA; p.MQ = ws + w.MQ; p.MK = ws + w.MK; p.Bc = ws + w.Bc; p.Mt = ws + w.Mt;
    p.S = ws + w.S; p.RS = ws + w.RS; p.Hm = ws + w.Hm; p.Aa = ws + w.Aa; p.AO = ws + w.AO; p.X1 = ws + w.X1; p.XN2 = ws + w.XN2; p.Hf = ws + w.Hf; p.SS = ws + w.SS; }
inline void bind_inputs(P& p, void* const* d_in, float* out) {
    p.x_prompt = (const float*)d_in[0]; p.x_sample = (const float*)d_in[1]; p.cache_k = (const float*)d_in[2]; p.cache_v = (const float*)d_in[3]; p.state_C = (const float*)d_in[4];
    p.state_n = (const float*)d_in[5]; p.state_m = (const float*)d_in[6]; p.state_conv = (const float*)d_in[7]; p.page_table = (const int*)d_in[8]; p.meta = (const float*)d_in[9];
    p.norm_mix = (const float*)d_in[10]; p.w_in = (const float*)d_in[11]; p.q_norm = (const float*)d_in[12]; p.k_norm = (const float*)d_in[13]; p.lambda_qk = (const float*)d_in[14];
    p.attn_out_norm = (const float*)d_in[15]; p.conv_w = (const float*)d_in[16]; p.conv_b = (const float*)d_in[17]; p.w_qm = (const float*)d_in[18]; p.w_km = (const float*)d_in[19];
    p.gate_bias = (const float*)d_in[20]; p.mlstm_out_norm = (const float*)d_in[21]; p.w_out = (const float*)d_in[22]; p.norm_ffn = (const float*)d_in[23]; p.w_up = (const float*)d_in[24];
    p.w_down = (const float*)d_in[25]; p.out = out;
}
NV_FN void st_inproj(const P& p NV_STREAM_DECL) {
    LAUNCH(k_rms_in, R_ALL, p);
    G g = mkG(p.XN, D_MODEL, p.w_in, PROJ_WIDTH, p.Z, PROJ_WIDTH, nullptr, 0, R_ALL, PROJ_WIDTH, D_MODEL, 1.f, 0); LAUNCH(k_gemm, gemm_threads(g), g);
}
NV_FN void st_post(const P& p NV_STREAM_DECL) {
    LAUNCH(k_qknorm, R_ALL * 4 * N_HEADS_A, p); LAUNCH(k_vout, R_ALL * ATT_WIDTH, p); LAUNCH(k_conv, R_ALL * MLSTM_WIDTH, p);
    for (int h = 0; h < N_HEADS_M; ++h) {
        G gq = mkG(p.UA + h * HEAD_DIM_M, MLSTM_WIDTH, p.w_qm + (size_t)h * HEAD_DIM_M * HEAD_DIM_M, HEAD_DIM_M, p.MQ + h * HEAD_DIM_M, MLSTM_WIDTH, nullptr, 0, R_ALL, HEAD_DIM_M, HEAD_DIM_M, 1.f, 0); LAUNCH(k_gemm, gemm_threads(gq), gq);
        G gk = mkG(p.UA + h * HEAD_DIM_M, MLSTM_WIDTH, p.w_km + (size_t)h * HEAD_DIM_M * HEAD_DIM_M, HEAD_DIM_M, p.MK + h * HEAD_DIM_M, MLSTM_WIDTH, nullptr, 0, R_ALL, HEAD_DIM_M, HEAD_DIM_M, 1.0f / sqrtf((float)HEAD_DIM_M), 0); LAUNCH(k_gemm, gemm_threads(gk), gk);
    }
}
NV_FN void st_mlstm(const P& p NV_STREAM_DECL) {
    LAUNCH(k_scan, BATCH * N_HEADS_M, p); LAUNCH(k_mscore, BATCH * N_HEADS_M * T * T, p); LAUNCH(k_mh, BATCH * N_HEADS_M * T * HEAD_DIM_M, p);
    LAUNCH(k_mstate, BATCH * N_HEADS_M * HEAD_DIM_M * (HEAD_DIM_M + 1), p);
    LAUNCH(k_smh, DEC_BATCH * N_HEADS_M * DEC_SEQ * HEAD_DIM_M, p); LAUNCH(k_smstate, DEC_BATCH * N_HEADS_M * HEAD_DIM_M * (HEAD_DIM_M + 1), p);
}
NV_FN void st_attn(const P& p NV_STREAM_DECL) {
    for (int b = 0; b < BATCH; ++b) { LAUNCH(k_ascore, N_HEADS_A * 2 * T * T, p, b); LAUNCH(k_astat, N_HEADS_A * 2 * T, p); LAUNCH(k_aout, N_HEADS_A * T * V_DIM_A, p, b); }
    LAUNCH(k_sscore, DEC_BATCH * N_HEADS_A * 2 * DEC_SEQ * TK_S, p); LAUNCH(k_sstat, DEC_BATCH * N_HEADS_A * 2 * DEC_SEQ, p); LAUNCH(k_sout, DEC_BATCH * N_HEADS_A * DEC_SEQ * V_DIM_A, p);
}
NV_FN void st_finish(const P& p NV_STREAM_DECL) {
    LAUNCH(k_mixout, R_FULL * (N_HEADS_A + N_HEADS_M), p);
    G g1 = mkG(p.AO, D_MODEL, p.w_out, D_MODEL, p.X1, D_MODEL, p.x_prompt, D_MODEL, R_PROMPT, D_MODEL, D_MODEL, 1.f, 0); LAUNCH(k_gemm, gemm_threads(g1), g1);
    G g2 = mkG(p.AO + (size_t)R_PROMPT * D_MODEL, D_MODEL, p.w_out, D_MODEL, p.X1 + (size_t)R_PROMPT * D_MODEL, D_MODEL, p.x_sample, D_MODEL, R_SAMPLE, D_MODEL, D_MODEL, 1.f, 0); LAUNCH(k_gemm, gemm_threads(g2), g2);
    LAUNCH(k_rms_ffn, R_FULL, p);
    G g3 = mkG(p.XN2, D_MODEL, p.w_up, D_FF, p.Hf, D_FF, nullptr, 0, R_FULL, D_FF, D_MODEL, 1.f, 1); LAUNCH(k_gemm, gemm_threads(g3), g3);
    G g4 = mkG(p.Hf, D_FF, p.w_down, D_MODEL, p.out + O_Y, D_MODEL, p.X1, D_MODEL, R_FULL, D_MODEL, D_FF, 1.f, 0); LAUNCH(k_gemm, gemm_threads(g4), g4);
}
NV_FN void naive_forward(const P& p NV_STREAM_DECL) {
    st_inproj(p NV_STREAM_USE); st_post(p NV_STREAM_USE); st_mlstm(p NV_STREAM_USE); st_attn(p NV_STREAM_USE); st_finish(p NV_STREAM_USE);
}
}

extern "C" void kernel_launch(void* const* d_in, const int* in_sizes, int n_in, void* d_out, int out_size, void* d_ws, size_t ws_size, hipStream_t stream) {
    nv::P p{}; nv::bind_inputs(p, d_in, (float*)d_out); nv::bind_ws(p, (float*)d_ws);
    nv::naive_forward(p, stream);
}
```

```cpp
#include <hip/hip_runtime.h>
#include <cstdio>
#include <cstdint>
#include <math.h>
namespace cfg {
#ifdef SMALL_CFG
constexpr int D_MODEL = 128, BATCH = 2, SEQ = 256, DEC_BATCH = 2, DEC_SEQ = 4, PAST_LEN = 256, PAGE_SIZE = 32, N_META = 16, HEAD_DIM_A = 16, N_HEADS_M = 2;
#else
constexpr int D_MODEL = 2048, BATCH = 4, SEQ = 2048, DEC_BATCH = 8, DEC_SEQ = 4, PAST_LEN = 16384, PAGE_SIZE = 128, N_META = 16, HEAD_DIM_A = 64, N_HEADS_M = 4;
#endif
constexpr int ATT_WIDTH = D_MODEL / 2, V_DIM_A = 2 * HEAD_DIM_A, N_HEADS_A = ATT_WIDTH / V_DIM_A;
constexpr int MLSTM_WIDTH = D_MODEL - ATT_WIDTH, HEAD_DIM_M = MLSTM_WIDTH / N_HEADS_M, CONV_W = 4, D_FF = 4 * D_MODEL;
constexpr int PROJ_WIDTH = 3 * ATT_WIDTH + 3 * MLSTM_WIDTH + 2 * N_HEADS_M;
constexpr int T = SEQ + N_META;
constexpr int N_PAGES = PAST_LEN / PAGE_SIZE;
constexpr int TK_S = PAST_LEN + DEC_SEQ;
constexpr float EPS = 1e-6f;
constexpr float LAM_INIT = 0.2f;
constexpr int R_PROMPT = BATCH * SEQ, R_SAMPLE = DEC_BATCH * DEC_SEQ, R_FULL = R_PROMPT + R_SAMPLE, R_ALL = R_FULL + N_META;
constexpr int ZQ = 0, ZK = ATT_WIDTH, ZV = 2 * ATT_WIDTH, ZU = 3 * ATT_WIDTH, ZVM = ZU + MLSTM_WIDTH, ZOG = ZVM + MLSTM_WIDTH, ZGI = ZOG + MLSTM_WIDTH, ZGF = ZGI + N_HEADS_M;
constexpr size_t O_Y = 0, O_YS = O_Y + (size_t)BATCH * SEQ * D_MODEL, O_KP = O_YS + (size_t)R_SAMPLE * D_MODEL,
    O_VP = O_KP + (size_t)BATCH * T * ATT_WIDTH, O_CP = O_VP + (size_t)BATCH * T * ATT_WIDTH,
    O_NP = O_CP + (size_t)BATCH * N_HEADS_M * HEAD_DIM_M * HEAD_DIM_M, O_MP = O_NP + (size_t)BATCH * N_HEADS_M * HEAD_DIM_M,
    O_CVP = O_MP + (size_t)BATCH * N_HEADS_M, O_KS = O_CVP + (size_t)BATCH * 3 * MLSTM_WIDTH, O_VS = O_KS + (size_t)R_SAMPLE * ATT_WIDTH,
    O_CS = O_VS + (size_t)R_SAMPLE * ATT_WIDTH, O_NS = O_CS + (size_t)DEC_BATCH * N_HEADS_M * HEAD_DIM_M * HEAD_DIM_M,
    O_MS = O_NS + (size_t)DEC_BATCH * N_HEADS_M * HEAD_DIM_M, O_CVS = O_MS + (size_t)DEC_BATCH * N_HEADS_M, O_END = O_CVS + (size_t)DEC_BATCH * 3 * MLSTM_WIDTH;
}
__device__ __forceinline__ int lane_now() { int l; asm volatile("v_mbcnt_lo_u32_b32 %0, -1, 0\n\tv_mbcnt_hi_u32_b32 %0, -1, %0" : "=v"(l)); return l; }
namespace pg8 {
#define PG8_LAS __attribute__((address_space(3)))
typedef unsigned short bf16_t;
typedef short bf16x8 __attribute__((ext_vector_type(8)));
typedef float f32x4 __attribute__((ext_vector_type(4)));
typedef unsigned u32x4 __attribute__((ext_vector_type(4)));
constexpr int BM = 256, BK = 64, HALF = 128, HTB = HALF * BK * 2  , STAGE_BYTES = 8 * HTB, NXCD = 8, WGM = 8;

__host__ __device__ __forceinline__ int lds_byte(int r, int c) { const int st = (r >> 4) * 2 + (c >> 5), rr = r & 15, cc = c & 31, ob = rr * 64 + cc * 2; return st * 1024 + (ob ^ (((ob >> 9) & 1) << 5)); }
__host__ __device__ __forceinline__ void stage_rc(int b, int& R, int& C) { const int st = b / 1024, sb = b % 1024, swz = sb ^ (((sb >> 9) & 1) << 5); R = (st >> 1) * 16 + swz / 64; C = (st & 1) * 32 + (swz % 64) / 2; }
__host__ __device__ __forceinline__ int perm32(int rho) { const int n = rho >> 4, i = rho & 15; return 8 * (i >> 2) + 4 * n + (i & 3); }

struct Unit { int pm, pn; };
struct Gemm { const bf16_t* A; const bf16_t* Bt; int M, N, K, lda, ldb;
    int pbt, skew_rows;
    int grp_pn, grp_a_cols;
    __device__ __forceinline__ size_t a_off(int pm, int pn) const { size_t r = (size_t)pm * BM; if (pbt) r += (size_t)(pm / pbt + 1) * skew_rows; size_t o = r * lda; if (grp_pn) o += (size_t)(pn / grp_pn) * grp_a_cols; return o * 2; } };

struct StaticOrder {
    int nM, nN, nwg, G, c;
    __host__ __device__ void init(int M, int N, int G_, int c_) { nM = M / BM; nN = N / BM; nwg = nM * nN; G = G_; c = c_; }
    __host__ __device__ bool next(int i, Unit& u) const {
        const long L = (long)i * G + c; if (L >= nwg) return false;
        int wgid = (int)L; { const int q = nwg / NXCD, r = nwg % NXCD, xcd = wgid % NXCD, off = wgid / NXCD; wgid = (xcd < r ? xcd * (q + 1) : r * (q + 1) + (xcd - r) * q) + off; }
        const int nig = WGM * nN, gid = wgid / nig, fm = gid * WGM, gsz = (nM - fm) < WGM ? (nM - fm) : WGM;
        u.pm = fm + ((wgid % nig) % gsz); u.pn = (wgid % nig) / gsz; return true;
    }
    __device__ __forceinline__ void a_ready(const Unit&) const {}
    __device__ __forceinline__ void done(const Unit&) const {}
};

struct RangeOrder { StaticOrder b; int lo, hi;
    __device__ __forceinline__ bool next(int i, Unit& u) const { return lo + i < hi && b.next(lo + i, u); }
    __device__ __forceinline__ void a_ready(const Unit&) const {}
    __device__ __forceinline__ void done(const Unit&) const {}
};
struct PairOrder { int pm, pn0;
    __device__ __forceinline__ bool next(int i, Unit& u) const { if (i >= 2) return false; u.pm = pm; u.pn = pn0 + i; return true; }
    __device__ __forceinline__ void a_ready(const Unit&) const {}
    __device__ __forceinline__ void done(const Unit&) const {}
};
__device__ __forceinline__ unsigned cvt_pk_bf16(float lo, float hi) { unsigned r; asm volatile("v_cvt_pk_bf16_f32 %0, %1, %2" : "=v"(r) : "v"(lo), "v"(hi)); return r; }
typedef unsigned u32x2 __attribute__((ext_vector_type(2)));
constexpr float RMS_EPS = 1e-6f;

struct EpiOutProj {
    static constexpr bool PERM = false, AFTER_DRAIN = true, B64 = false;
    const float* resid; float* x1; bf16_t* xn2; const float* gain; float* ssq; int ldc;
    __device__ __forceinline__ void fused(f32x4 (&acc)[2][2][4][2], const Unit& u, int wr, int wc, int fr, int fq, PG8_LAS unsigned char* lds, int wid, int lane) const {
        PG8_LAS float* P = (PG8_LAS float*)lds;
        const int col0 = u.pn * BM + wc * 32 + 4 * fq;
        f32x4 gv[2][2];
#pragma unroll
        for (int bj = 0; bj < 2; ++bj)
#pragma unroll
            for (int n = 0; n < 2; ++n) gv[bj][n] = *(const f32x4*)(gain + col0 + bj * HALF + n * 16);
#pragma unroll
        for (int ai = 0; ai < 2; ++ai) { f32x4 rs[4][2][2];
#pragma unroll
            for (int m = 0; m < 4; ++m) { const size_t off = (size_t)(u.pm * BM + ai * HALF + wr * 64 + m * 16 + fr) * ldc + col0;
#pragma unroll
                for (int bj = 0; bj < 2; ++bj)
#pragma unroll
                    for (int n = 0; n < 2; ++n) rs[m][bj][n] = *(const f32x4*)(resid + off + bj * HALF + n * 16); }
#pragma unroll
            for (int m = 0; m < 4; ++m) { const int r = ai * HALF + wr * 64 + m * 16 + fr; const size_t off = (size_t)(u.pm * BM + r) * ldc + col0; float s = 0.f;
#pragma unroll
                for (int bj = 0; bj < 2; ++bj)
#pragma unroll
                    for (int n = 0; n < 2; ++n) { const f32x4 x = rs[m][bj][n] + acc[ai][bj][m][n];
                        *(f32x4*)(x1 + off + bj * HALF + n * 16) = x; s += (x[0] * x[0] + x[1] * x[1]) + (x[2] * x[2] + x[3] * x[3]);
                        const f32x4 y = x * gv[bj][n]; u32x2 w; w.x = cvt_pk_bf16(y[0], y[1]); w.y = cvt_pk_bf16(y[2], y[3]); *(u32x2*)(xn2 + off + bj * HALF + n * 16) = w; }
                s += __shfl_xor(s, 16); s += __shfl_xor(s, 32);
                if (fq == 0) P[r * 4 + wc] = s; }
            asm volatile("" ::: "memory"); }
        asm volatile("s_waitcnt lgkmcnt(0)" ::: "memory"); __builtin_amdgcn_s_barrier(); asm volatile("" ::: "memory");
        const int tid = wid * 64 + lane;
        if (tid < BM) ssq[(size_t)(u.pm * BM + tid) * 8 + u.pn] = (P[tid * 4 + 0] + P[tid * 4 + 1]) + (P[tid * 4 + 2] + P[tid * 4 + 3]);
    }
};
struct EpiUp {
    static constexpr bool PERM = true, AFTER_DRAIN = false, B64 = false;
    bf16_t* O; int ldc; const float* ssq; float inv_n;
    __device__ __forceinline__ void operator()(const f32x4 (&acc)[2][2][4][2], const Unit& u, int wr, int wc, int fr, int fq) const {
        const int row0 = u.pm * BM + wr * 64 + fr, col0 = u.pn * BM + wc * 32 + 8 * fq;
#pragma unroll
        for (int ai = 0; ai < 2; ++ai)
#pragma unroll
            for (int m = 0; m < 4; ++m) { const int row = row0 + ai * HALF + m * 16; const f32x4 a = *(const f32x4*)(ssq + (size_t)row * 8), b = *(const f32x4*)(ssq + (size_t)row * 8 + 4);
                const float rs = 1.0f / sqrtf(((a[0] + a[1]) + (a[2] + a[3]) + (b[0] + b[1]) + (b[2] + b[3])) * inv_n + RMS_EPS);
                bf16_t* rowp = O + (size_t)row * ldc + col0;
#pragma unroll
                for (int bj = 0; bj < 2; ++bj) { f32x4 v0 = acc[ai][bj][m][0] * rs, v1 = acc[ai][bj][m][1] * rs;
#pragma unroll
                    for (int j = 0; j < 4; ++j) { v0[j] = v0[j] > 0.f ? v0[j] * v0[j] : 0.f; v1[j] = v1[j] > 0.f ? v1[j] * v1[j] : 0.f; }
                    u32x4 w; w.x = cvt_pk_bf16(v0[0], v0[1]); w.y = cvt_pk_bf16(v0[2], v0[3]); w.z = cvt_pk_bf16(v1[0], v1[1]); w.w = cvt_pk_bf16(v1[2], v1[3]);
                    *(u32x4*)(rowp + bj * HALF) = w; } }
    }
};
struct EpiDown {
    static constexpr bool PERM = false, AFTER_DRAIN = false, B64 = false;
    const float* x1; float* out; int ldc;
    __device__ __forceinline__ void operator()(const f32x4 (&acc)[2][2][4][2], const Unit& u, int wr, int wc, int fr, int fq) const {
        const int col0 = u.pn * BM + wc * 32 + 4 * fq;
#pragma unroll
        for (int ai = 0; ai < 2; ++ai) { f32x4 rs[4][2][2];
#pragma unroll
            for (int m = 0; m < 4; ++m) { const size_t off = (size_t)(u.pm * BM + ai * HALF + wr * 64 + m * 16 + fr) * ldc + col0;
#pragma unroll
                for (int bj = 0; bj < 2; ++bj)
#pragma unroll
                    for (int n = 0; n < 2; ++n) rs[m][bj][n] = *(const f32x4*)(x1 + off + bj * HALF + n * 16); }
#pragma unroll
            for (int m = 0; m < 4; ++m) { const size_t off = (size_t)(u.pm * BM + ai * HALF + wr * 64 + m * 16 + fr) * ldc + col0;
#pragma unroll
                for (int bj = 0; bj < 2; ++bj)
#pragma unroll
                    for (int n = 0; n < 2; ++n) *(f32x4*)(out + off + bj * HALF + n * 16) = rs[m][bj][n] + acc[ai][bj][m][n]; }
            asm volatile("" ::: "memory"); }
    }
};
struct EpiInProj {
    static constexpr bool PERM = true, AFTER_DRAIN = false, B64 = true;
    bf16_t *Qs, *Ks, *Vs, *Us, *VMs, *OGs; float *okp, *ovp, *ocvp; const float *q_g, *k_g; float qscale; int T_, SEQ_, NMETA_;
    __device__ __forceinline__ void operator()(const f32x4 (&acc)[2][2][4][2], const Unit& u, int wr, int wc, int fr, int fq) const {
        const int typ = u.pn >> 2, b = (u.pm * BM) / SEQ_, s0 = (u.pm * BM) % SEQ_ + wr * 64 + fr;
        const unsigned cb = (unsigned)((u.pn & 3) * 256 + wc * 64 + 8 * fq);
        const unsigned off0 = ((unsigned)(b * T_ + NMETA_ + s0)) * 1024u + cb;
        bf16_t* dst = typ == 0 ? Qs : typ == 1 ? Ks : typ == 2 ? Vs : typ == 3 ? Us : typ == 4 ? VMs : OGs;
        float* fo = typ == 1 ? okp : typ == 2 ? ovp : nullptr;
        const bool nrm = typ <= 1; const float sc = typ == 0 ? qscale : 1.0f;
        f32x4 gv[2][2];
#pragma unroll
        for (int bj = 0; bj < 2; ++bj)
#pragma unroll
            for (int n = 0; n < 2; ++n) gv[bj][n] = nrm ? *(const f32x4*)((typ ? k_g : q_g) + 8 * fq + 32 * bj + 4 * n) : (f32x4){1.f, 1.f, 1.f, 1.f};
#pragma unroll
        for (int ai = 0; ai < 2; ++ai)
#pragma unroll
            for (int m = 0; m < 4; ++m) { float rr = sc;
                if (nrm) { float ss = 0.f;
#pragma unroll
                    for (int bj = 0; bj < 2; ++bj)
#pragma unroll
                        for (int n = 0; n < 2; ++n) { const f32x4 x = acc[ai][bj][m][n]; ss += (x[0] * x[0] + x[1] * x[1]) + (x[2] * x[2] + x[3] * x[3]); }
                    ss += __shfl_xor(ss, 16); ss += __shfl_xor(ss, 32);
                    rr = sc / sqrtf(ss * (1.0f / 64.0f) + RMS_EPS); }
                const unsigned off = off0 + (unsigned)(ai * HALF + m * 16) * 1024u; const int s = s0 + ai * HALF + m * 16;
#pragma unroll
                for (int bj = 0; bj < 2; ++bj) { const f32x4 v0 = acc[ai][bj][m][0] * rr * gv[bj][0], v1 = acc[ai][bj][m][1] * rr * gv[bj][1];
                    if (fo) { float* o = fo + off + 32 * bj; *(f32x4*)o = v0; *(f32x4*)(o + 4) = v1; }
                    if (typ == 3 && s >= SEQ_ - 3) { float* o = ocvp + (unsigned)((b * 3 + (s - (SEQ_ - 3))) * 1024) + cb + 32 * bj; *(f32x4*)o = v0; *(f32x4*)(o + 4) = v1; }
                    u32x4 w; w.x = cvt_pk_bf16(v0[0], v0[1]); w.y = cvt_pk_bf16(v0[2], v0[3]); w.z = cvt_pk_bf16(v1[0], v1[1]); w.w = cvt_pk_bf16(v1[2], v1[3]);
                    *(u32x4*)(dst + off + 32 * bj) = w; }
                asm volatile("" ::: "memory"); }
    }
};
struct EpiQK {
    static constexpr bool PERM = true, AFTER_DRAIN = false, B64 = false;
    bf16_t* MQs; long long kdelta; int T_, SEQ_, NMETA_, pad_;
    __device__ __forceinline__ void operator()(const f32x4 (&acc)[2][2][4][2], const Unit& u, int wr, int wc, int fr, int fq) const {
        const int head = u.pn >> 1, b = (u.pm * BM) / SEQ_, s0 = (u.pm * BM) % SEQ_ + wr * 64 + fr; bf16_t* dst = MQs + (long long)(u.pn & 1) * kdelta;
        const unsigned off0 = ((unsigned)(b * T_ + NMETA_ + s0)) * 1024u + (unsigned)(head * 256 + wc * 32 + 8 * fq);
#pragma unroll
        for (int ai = 0; ai < 2; ++ai)
#pragma unroll
            for (int m = 0; m < 4; ++m) { const unsigned off = off0 + (unsigned)(ai * HALF + m * 16) * 1024u;
#pragma unroll
                for (int bj = 0; bj < 2; ++bj) { const f32x4 v0 = acc[ai][bj][m][0], v1 = acc[ai][bj][m][1];
                    u32x4 w; w.x = cvt_pk_bf16(v0[0], v0[1]); w.y = cvt_pk_bf16(v0[2], v0[3]); w.z = cvt_pk_bf16(v1[0], v1[1]); w.w = cvt_pk_bf16(v1[2], v1[3]);
                    *(u32x4*)(dst + off + bj * HALF) = w; }
                asm volatile("" ::: "memory"); }
    }
};
struct EpiQKwt {
    static constexpr bool PERM = true, AFTER_DRAIN = false, B64 = false;
    bf16_t* MQs; long long kdelta; int T_, SEQ_, NMETA_, rs_bytes;
    __device__ __forceinline__ void operator()(const f32x4 (&acc)[2][2][4][2], const Unit& u, int wr, int wc, int fr, int fq) const {
        const int head = u.pn >> 1, b = (u.pm * BM) / SEQ_, s0 = (u.pm * BM) % SEQ_ + wr * 64 + fr; const __amdgpu_buffer_rsrc_t rs = __builtin_amdgcn_make_buffer_rsrc((void*)(MQs + (long long)(u.pn & 1) * kdelta), 0, rs_bytes, 0x00020000);
        const unsigned off0 = ((unsigned)(b * T_ + NMETA_ + s0)) * 1024u + (unsigned)(head * 256 + wc * 32 + 8 * fq);
#pragma unroll
        for (int ai = 0; ai < 2; ++ai)
#pragma unroll
            for (int m = 0; m < 4; ++m) { const unsigned off = off0 + (unsigned)(ai * HALF + m * 16) * 1024u;
#pragma unroll
                for (int bj = 0; bj < 2; ++bj) { const f32x4 v0 = acc[ai][bj][m][0], v1 = acc[ai][bj][m][1];
                    u32x4 w; w.x = cvt_pk_bf16(v0[0], v0[1]); w.y = cvt_pk_bf16(v0[2], v0[3]); w.z = cvt_pk_bf16(v1[0], v1[1]); w.w = cvt_pk_bf16(v1[2], v1[3]);
                    __builtin_amdgcn_raw_buffer_store_b128(w, rs, (int)((off + bj * HALF) * 2u), 0, 16); }
                asm volatile("" ::: "memory"); }
    }
};
template <class Epi, class Sched, bool ALIGN_EPI = false, bool SP2 = false>
__device__ __forceinline__ void gemm_phase(PG8_LAS unsigned char* lds, const Gemm g, const Sched& S, const Epi& E, const int wave_) {
    const int tid_ = wave_ * 64 + lane_now();
    const int tid = tid_, wid = wave_, lane = tid & 63, wr = wid >> 2, wc = wid & 3, fr = lane & 15, fq = lane >> 4;
    const int K = g.K, nt = K / BK;
    unsigned voffA[2], voffB[2];
#pragma unroll
    for (int i = 0; i < 2; ++i) { int R, C; stage_rc(tid * 16 + i * 8192, R, C); const int Rb = Epi::PERM ? ((R & ~31) + perm32(R & 31)) : R;
        const int Rb2 = Epi::B64 ? ((Rb >> 5) * 64 + (Rb & 31)) : Rb;
        voffA[i] = (unsigned)(R * g.lda + C) * 2u; voffB[i] = (unsigned)(Rb2 * g.ldb + C) * 2u; }
    const size_t kstep = (size_t)(BK * 2);
    const size_t hstepA = (size_t)HALF * g.lda * 2;
    const size_t hstepB = (size_t)(Epi::B64 ? 32 : HALF) * g.ldb * 2;
    const size_t tstepB = (size_t)BM * g.ldb * 2;
    const unsigned ldsw = (unsigned)wid * 1024u;
    const int aoff = lds_byte(wr * 64 + fr, fq * 8), boff = lds_byte(wc * 32 + fr, fq * 8);
#define PG8_SA(b, h) (((b) * 2 + (h)) * HTB)
#define PG8_SB(b, h) ((4 + (b) * 2 + (h)) * HTB)
#define PG8_STAGE(bufoff, gbase, voff) do { _Pragma("unroll") for (int _i = 0; _i < 2; ++_i) \
        __builtin_amdgcn_global_load_lds((const unsigned*)((const char*)(gbase) + (voff)[_i]), (PG8_LAS unsigned*)(lds + (bufoff) + ldsw + _i * 8192), 16, 0, 0); } while (0)
#define PG8_LDA(dst, b, h) do { _Pragma("unroll") for (int m = 0; m < 4; ++m) _Pragma("unroll") for (int k = 0; k < 2; ++k) dst[m][k] = *(const PG8_LAS bf16x8*)(lds + PG8_SA(b, h) + aoff + m * 2048 + k * 1024); } while (0)
#define PG8_LDB(dst, b, h) do { _Pragma("unroll") for (int n = 0; n < 2; ++n) _Pragma("unroll") for (int k = 0; k < 2; ++k) dst[n][k] = *(const PG8_LAS bf16x8*)(lds + PG8_SB(b, h) + boff + n * 2048 + k * 1024); } while (0)
#define PG8_MMA(ai, bj, At, Bt) do { __builtin_amdgcn_s_setprio(1); _Pragma("unroll") for (int m = 0; m < 4; ++m) _Pragma("unroll") for (int n = 0; n < 2; ++n) _Pragma("unroll") for (int k = 0; k < 2; ++k) \
        acc[ai][bj][m][n] = __builtin_amdgcn_mfma_f32_16x16x32_bf16(Bt[n][k], At[m][k], acc[ai][bj][m][n], 0, 0, 0); __builtin_amdgcn_s_setprio(0); } while (0)
#define PG8_WAIT_V(n) asm volatile("s_waitcnt vmcnt(" #n ")" ::: "memory")
#define PG8_WAIT_L(n) asm volatile("s_waitcnt lgkmcnt(" #n ")" ::: "memory")
#define PG8_BAR __builtin_amdgcn_s_barrier()
#define PG8_SCHED __builtin_amdgcn_sched_barrier(0)
    Unit cur, nxt; int ui = 0;
    if (!S.next(0, cur)) return;
    f32x4 acc[2][2][4][2];
#pragma unroll
    for (int a = 0; a < 2; ++a)
#pragma unroll
        for (int b = 0; b < 2; ++b)
#pragma unroll
            for (int m = 0; m < 4; ++m)
#pragma unroll
                for (int n = 0; n < 2; ++n) acc[a][b][m][n] = (f32x4){0.f, 0.f, 0.f, 0.f};
    bf16x8 At[4][2], B0[2][2], B1[2][2];
    const char* cA = (const char*)g.A + g.a_off(cur.pm, cur.pn); const char* cB = (const char*)g.Bt + (size_t)cur.pn * tstepB;
    S.a_ready(cur);
    if constexpr (SP2) {
        PG8_STAGE(PG8_SB(0, 0), cB, voffB); PG8_STAGE(PG8_SB(0, 1), cB + hstepB, voffB); PG8_STAGE(PG8_SA(0, 0), cA, voffA); PG8_STAGE(PG8_SA(0, 1), cA + hstepA, voffA);
        if (wr == 1) PG8_BAR;
        PG8_WAIT_V(2); PG8_BAR;
        PG8_STAGE(PG8_SB(1, 0), cB + kstep, voffB); PG8_STAGE(PG8_SA(1, 0), cA + kstep, voffA); PG8_STAGE(PG8_SB(1, 1), cB + hstepB + kstep, voffB);
        PG8_WAIT_V(6); PG8_BAR;
    } else {
        PG8_STAGE(PG8_SB(0, 0), cB, voffB); PG8_STAGE(PG8_SA(0, 0), cA, voffA); PG8_STAGE(PG8_SB(0, 1), cB + hstepB, voffB); PG8_STAGE(PG8_SA(0, 1), cA + hstepA, voffA);
        if (wr == 1) PG8_BAR;
        PG8_WAIT_V(4); PG8_BAR;
        PG8_STAGE(PG8_SB(1, 0), cB + kstep, voffB); PG8_STAGE(PG8_SA(1, 0), cA + kstep, voffA); PG8_STAGE(PG8_SB(1, 1), cB + hstepB + kstep, voffB);
        PG8_WAIT_V(6); PG8_BAR;
    }
    for (;;) {
        const bool has_next = S.next(ui + 1, nxt);
        const char* nA = has_next ? (const char*)g.A + g.a_off(nxt.pm, nxt.pn) : cA; const char* nB = has_next ? (const char*)g.Bt + (size_t)nxt.pn * tstepB : cB;
#pragma nounroll
        for (int t = 0; t < nt; t += 2) {
            const bool last = (t == nt - 2);
            const char* a1 = cA + (size_t)(t + 1) * kstep;
            const char* a2 = last ? nA : cA + (size_t)(t + 2) * kstep; const char* b2 = last ? nB : cB + (size_t)(t + 2) * kstep;
            const char* a3 = a2 + kstep; const char* b3 = b2 + kstep;
            if (last && has_next) S.a_ready(nxt);
            if constexpr (SP2) {
            PG8_LDB(B0, 0, 0); PG8_LDB(B1, 0, 1); PG8_SCHED; PG8_LDA(At, 0, 0); PG8_STAGE(PG8_SA(1, 1), a1 + hstepA, voffA);
            PG8_WAIT_V(8); PG8_WAIT_L(0); PG8_BAR; PG8_MMA(0, 0, At, B0); PG8_MMA(0, 1, At, B1); PG8_BAR; PG8_SCHED;
            PG8_LDA(At, 0, 1); PG8_STAGE(PG8_SB(0, 0), b2, voffB); PG8_STAGE(PG8_SB(0, 1), b2 + hstepB, voffB); PG8_STAGE(PG8_SA(0, 0), a2, voffA);
            PG8_WAIT_V(8); PG8_WAIT_L(0); PG8_BAR; PG8_MMA(1, 0, At, B0); PG8_MMA(1, 1, At, B1); PG8_BAR; PG8_SCHED;
            PG8_LDB(B0, 1, 0); PG8_LDB(B1, 1, 1); PG8_SCHED; PG8_LDA(At, 1, 0); PG8_STAGE(PG8_SA(0, 1), a2 + hstepA, voffA);
            PG8_WAIT_V(8); PG8_WAIT_L(0); PG8_BAR; PG8_MMA(0, 0, At, B0); PG8_MMA(0, 1, At, B1); PG8_BAR; PG8_SCHED;
            PG8_LDA(At, 1, 1); PG8_STAGE(PG8_SB(1, 0), b3, voffB); PG8_STAGE(PG8_SB(1, 1), b3 + hstepB, voffB); PG8_STAGE(PG8_SA(1, 0), a3, voffA);
            PG8_WAIT_V(8); PG8_WAIT_L(0); PG8_BAR; PG8_MMA(1, 0, At, B0); PG8_MMA(1, 1, At, B1); PG8_BAR; PG8_SCHED;
            } else {
            PG8_LDB(B0, 0, 0); PG8_SCHED; PG8_LDA(At, 0, 0); PG8_STAGE(PG8_SA(1, 1), a1 + hstepA, voffA);
            PG8_WAIT_L(8); PG8_BAR; PG8_WAIT_L(0); PG8_MMA(0, 0, At, B0); PG8_BAR; PG8_SCHED;
            PG8_LDB(B1, 0, 1); PG8_STAGE(PG8_SB(0, 0), b2, voffB);
            PG8_BAR; PG8_WAIT_L(0); PG8_MMA(0, 1, At, B1); PG8_BAR;
            PG8_LDA(At, 0, 1); PG8_STAGE(PG8_SA(0, 0), a2, voffA);
            PG8_BAR; PG8_WAIT_L(0); PG8_MMA(1, 0, At, B0); PG8_BAR; PG8_SCHED;
            PG8_STAGE(PG8_SB(0, 1), b2 + hstepB, voffB);
            PG8_WAIT_V(6); PG8_BAR; PG8_MMA(1, 1, At, B1); PG8_BAR;
            PG8_LDB(B0, 1, 0); PG8_SCHED; PG8_LDA(At, 1, 0); PG8_STAGE(PG8_SA(0, 1), a2 + hstepA, voffA);
            PG8_WAIT_L(8); PG8_BAR; PG8_WAIT_L(0); PG8_MMA(0, 0, At, B0); PG8_BAR; PG8_SCHED;
            PG8_LDB(B1, 1, 1); PG8_STAGE(PG8_SB(1, 0), b3, voffB);
            PG8_BAR; PG8_WAIT_L(0); PG8_MMA(0, 1, At, B1); PG8_BAR;
            PG8_LDA(At, 1, 1); PG8_STAGE(PG8_SA(1, 0), a3, voffA);
            PG8_BAR; PG8_WAIT_L(0); PG8_MMA(1, 0, At, B0); PG8_BAR; PG8_SCHED;
            PG8_STAGE(PG8_SB(1, 1), b3 + hstepB, voffB);
            PG8_WAIT_V(6); PG8_BAR; PG8_MMA(1, 1, At, B1); PG8_BAR;
            }
        }
        if constexpr (ALIGN_EPI) { if (wr == 0) PG8_BAR; }
        if constexpr (!Epi::AFTER_DRAIN) { E(acc, cur, wr, wc, fr, fq); S.done(cur); }
        if (!has_next) break;
#pragma unroll
        for (int a = 0; a < 2; ++a)
#pragma unroll
            for (int b = 0; b < 2; ++b)
#pragma unroll
                for (int m = 0; m < 4; ++m)
#pragma unroll
                    for (int n = 0; n < 2; ++n) acc[a][b][m][n] = (f32x4){0.f, 0.f, 0.f, 0.f};
        cur = nxt; cA = nA; cB = nB; ++ui;
        if constexpr (ALIGN_EPI) { if (wr == 1) PG8_BAR; }
    }
    PG8_WAIT_V(0);
    if constexpr (!ALIGN_EPI) { if (wr == 0) PG8_BAR; }
    PG8_BAR;
    if constexpr (Epi::AFTER_DRAIN) { E.fused(acc, cur, wr, wc, fr, fq, lds, wid, lane); S.done(cur); }
#undef PG8_SA
#undef PG8_SB
#undef PG8_STAGE
#undef PG8_LDA
#undef PG8_LDB
#undef PG8_MMA
#undef PG8_WAIT_V
#undef PG8_WAIT_L
#undef PG8_BAR
#undef PG8_SCHED
}
}
#define GAS __attribute__((address_space(1)))
#define LAS __attribute__((address_space(3)))
typedef unsigned short bf16;
typedef unsigned v4u __attribute__((ext_vector_type(4)));
typedef float f32x4 __attribute__((ext_vector_type(4)));
typedef short bf16x8 __attribute__((ext_vector_type(8)));
typedef GAS unsigned gu32;
typedef GAS unsigned long long gu64;
#define RLX_AGENT __ATOMIC_RELAXED, __HIP_MEMORY_SCOPE_AGENT
#define LDS_WAIT() asm volatile("s_waitcnt lgkmcnt(0)" ::: "memory")
#define VM_WAIT() asm volatile("s_waitcnt vmcnt(0)" ::: "memory")
__device__ __forceinline__ unsigned long long rt() { return __builtin_amdgcn_s_memrealtime(); }
__device__ __forceinline__ unsigned f2bf(float f) { unsigned u = __builtin_bit_cast(unsigned, f); return (u + 0x7fffu + ((u >> 16) & 1u)) >> 16; }
__device__ __forceinline__ unsigned pk2(float lo, float hi) { return f2bf(lo) | (f2bf(hi) << 16); }

#define XB_TMO      128
#define XB_XCNT(j)  (256  + 64 * (j))
#define XB_XSUB(j)  (1280 + 64 * (j))
#define XB_XGEN(j)  (2304 + 64 * (j))
#define XB_TOP      3328
#define XB_TOPGEN   3392
#define XCD_BAR_WORDS 3456
#define XB_SPIN_CAP (1u << 18)

__device__ __forceinline__ unsigned xb_ld(unsigned* p)              { return __hip_atomic_load(p, __ATOMIC_RELAXED, __HIP_MEMORY_SCOPE_AGENT); }
__device__ __forceinline__ unsigned xb_add(unsigned* p, unsigned v) { return __hip_atomic_fetch_add(p, v, __ATOMIC_RELAXED, __HIP_MEMORY_SCOPE_AGENT); }
__device__ __forceinline__ unsigned xb_xcc_id() { return (unsigned)__builtin_amdgcn_s_getreg((3 << 11) | 20) & 0xFu; }
#define XB_SPIN(cond, bar) do { unsigned _sp = 0; while (cond) { __builtin_amdgcn_s_sleep(1); \
    if ((++_sp & 255u) == 0u) { if (xb_ld(&(bar)[XB_TMO])) break; if (_sp > XB_SPIN_CAP) { atomicAdd(&(bar)[XB_TMO], 1u); break; } } } } while (0)

struct XcdBarrier {
    unsigned* bar; unsigned x;
    volatile LAS unsigned* st;
};

__device__ __forceinline__ XcdBarrier xcd_barrier_post(unsigned* bar, volatile LAS unsigned* st) {
    XcdBarrier b; b.bar = bar; b.x = xb_xcc_id(); b.st = st;
    if (threadIdx.x == 0) (void)xb_add(&bar[XB_XCNT(b.x)], 1u);
    return b;
}
__device__ __forceinline__ void xcd_barrier_complete(unsigned* bar, unsigned x, unsigned& nloc, unsigned& nx) {
    const unsigned G = gridDim.x * gridDim.y * gridDim.z;
    unsigned sum, cnt, mine, sp = 0u;
    for (;;) {
        sum = 0u; cnt = 0u; mine = 0u;
#pragma unroll
        for (unsigned j = 0; j < 16; ++j) { const unsigned c = xb_ld(&bar[XB_XCNT(j)]); sum += c; cnt += (c > 0u) ? 1u : 0u; mine = (j == x) ? c : mine; }
        if (sum == G) break;
        __builtin_amdgcn_s_sleep(1);
        if ((++sp & 255u) == 0u) { if (xb_ld(&bar[XB_TMO])) break; if (sp > XB_SPIN_CAP) { atomicAdd(&bar[XB_TMO], 1u); break; } }
    }
    nloc = mine > 0u ? mine : 1u; nx = cnt > 0u ? cnt : 1u;
}

__device__ __forceinline__ void xcd_barrier(const XcdBarrier& b, const int wave_) {
    asm volatile("s_waitcnt vmcnt(0)" ::: "memory");
    __syncthreads();
    if (wave_ == 0 && lane_now() == 0) {
        unsigned* bar = b.bar;
        __builtin_amdgcn_s_waitcnt(0);
        unsigned nloc = b.st[0], nx = b.st[1];
        if (nloc == 0u) { xcd_barrier_complete(bar, b.x, nloc, nx); b.st[0] = nloc; b.st[1] = nx; }
        const unsigned old = xb_add(&bar[XB_XSUB(b.x)], 1u);
        const unsigned gen = old / nloc;
        if (old + 1u == (gen + 1u) * nloc) {
            __builtin_amdgcn_fence(__ATOMIC_RELEASE, "agent");
            asm volatile("s_waitcnt vmcnt(0)" ::: "memory");
            const unsigned og = xb_add(&bar[XB_TOP], 1u);
            const unsigned tg = og / nx;
            if (og + 1u == (tg + 1u) * nx) xb_add(&bar[XB_TOPGEN], 1u);
            else XB_SPIN(xb_ld(&bar[XB_TOPGEN]) == tg, bar);
            __builtin_amdgcn_fence(__ATOMIC_ACQUIRE, "agent");
            xb_add(&bar[XB_XGEN(b.x)], 1u);
            asm volatile("s_waitcnt vmcnt(0)" ::: "memory");
        } else {
            XB_SPIN(xb_ld(&bar[XB_XGEN(b.x)]) == gen, bar);
            __builtin_amdgcn_fence(__ATOMIC_ACQUIRE, "agent");
            asm volatile("s_waitcnt vmcnt(0)" ::: "memory");
        }
    }
    __syncthreads();
}
namespace att {
using namespace cfg;
typedef float f32x16 __attribute__((ext_vector_type(16)));
typedef short s16x4 __attribute__((ext_vector_type(4)));
typedef short v4i16_t __attribute__((ext_vector_type(4)));
typedef unsigned u32x4 __attribute__((ext_vector_type(4)));
constexpr int ST_K = 0, ST_V = 16384, ST_BYTES = 32768;
__device__ __forceinline__ int crow(int i, int hh) { return (i & 3) + 8 * (i >> 2) + 4 * hh; }
__device__ __forceinline__ float swapmax(float x) { auto rr = __builtin_amdgcn_permlane32_swap(__float_as_uint(x), __float_as_uint(x), false, false); return fmaxf(__uint_as_float(rr[0]), __uint_as_float(rr[1])); }
__device__ __forceinline__ float swapadd(float x) { auto rr = __builtin_amdgcn_permlane32_swap(__float_as_uint(x), __float_as_uint(x), false, false); return __uint_as_float(rr[0]) + __uint_as_float(rr[1]); }
__device__ __forceinline__ s16x4 vtr(const LAS unsigned char* p) { return __builtin_bit_cast(s16x4, __builtin_amdgcn_ds_read_tr16_b64_v4i16((LAS v4i16_t*)p)); }
__device__ __forceinline__ unsigned pkbf(float lo, float hi) { unsigned r; asm volatile("v_cvt_pk_bf16_f32 %0, %1, %2" : "=v"(r) : "v"(lo), "v"(hi)); return r; }
__device__ __forceinline__ void glds16(const void* gsrc, const LAS unsigned char* dst) { unsigned keep; const unsigned d = (unsigned)__builtin_amdgcn_readfirstlane((int)(unsigned)(uintptr_t)dst);
    asm volatile("s_mov_b32 %0, m0\n\ts_mov_b32 m0, %2\n\ts_nop 0\n\tglobal_load_lds_dwordx4 %1, off\n\ts_mov_b32 m0, %0" : "=&s"(keep) : "v"(gsrc), "s"(d) : "memory"); }
#define ATT_MFMA(a, b, c) __builtin_amdgcn_mfma_f32_32x32x16_bf16((a), (b), (c), 0, 0, 0)

struct AttnArgs { const bf16 *Qs, *Ks, *Vs; bf16* AO; const float* gain; float lam, one_minus_lam_init; };

__device__ __forceinline__ void stage_tile(const AttnArgs& A, LAS unsigned char* st, int rowbase, int t, int h, int wave, int lane) {
#pragma unroll
    for (int i = 0; i < 2; ++i) { const int c = 2 * wave + i; int key = 64 * t + lane; key = key < T ? key : T - 1;
        glds16(A.Ks + (size_t)(rowbase + key) * 1024 + h * 128 + c * 8, st + ST_K + c * 1024); }
#pragma unroll
    for (int i = 0; i < 2; ++i) { const int p = 2 * wave + i, eb = p >> 2, rg = p & 3; int key = 64 * t + 16 * rg + (lane >> 2); key = key < T ? key : T - 1;
        glds16(A.Vs + (size_t)(rowbase + key) * 1024 + h * 128 + eb * 32 + (lane & 3) * 8, st + ST_V + p * 1024); }
}

__device__ __forceinline__ void attn_unit(const AttnArgs& A, LAS unsigned char* lds, int b, int h, int jb, int tid, int wave, int lane) {
    const int m = wave & 1, qs = wave >> 1, r = lane & 31, hh = lane >> 5;
    const int rowbase = b * T, qp0 = N_META + 128 * jb + 32 * qs, qpos = qp0 + r, NT = 2 * jb + 3;
    const float sl2 = exp2f(-8.0f * (float)(h + 1) / (float)N_HEADS_A) * 1.4426950408889634f;
    bf16x8 qf[4];
    { const bf16* qp = A.Qs + (size_t)(rowbase + qpos) * 1024 + h * 128 + m * 64 + 8 * hh;
#pragma unroll
      for (int ds = 0; ds < 4; ++ds) qf[ds] = *(const GAS bf16x8*)(qp + 16 * ds); }
    asm volatile("s_waitcnt vmcnt(0)" : "+v"(qf[0]), "+v"(qf[1]), "+v"(qf[2]), "+v"(qf[3]) :: "memory");
    f32x16 o[4];
#pragma unroll
    for (int e = 0; e < 4; ++e)
#pragma unroll
        for (int i = 0; i < 16; ++i) o[e][i] = 0.f;
    float m_run = 0.f, l_run = 0.f; constexpr float ATT_THR = 8.0f;
    const LAS unsigned char* vlane = lds + ST_V + ((lane >> 4) & 1) * 32 + (lane & 3) * 8 + (4 * hh + ((lane & 15) >> 2)) * 64;
    stage_tile(A, lds, rowbase, 0, h, wave, lane);
    if (NT > 1) stage_tile(A, lds + ST_BYTES, rowbase, 1, h, wave, lane);
    int sto = 0, stn = 2 * ST_BYTES;
    for (int t = 0; t < NT; ++t) {
        if (t + 1 < NT) asm volatile("s_waitcnt vmcnt(4)" ::: "memory"); else asm volatile("s_waitcnt vmcnt(0)" ::: "memory");
        asm volatile("s_waitcnt lgkmcnt(0)" ::: "memory"); __builtin_amdgcn_s_barrier(); asm volatile("" ::: "memory");
        if (t + 2 < NT) stage_tile(A, lds + stn, rowbase, t + 2, h, wave, lane);
        if (64 * t <= qp0 + 31) {
            const LAS unsigned char* Kst = lds + sto + ST_K + (m * 8 + hh) * 1024 + r * 16;
            f32x16 p0, p1; const float tb = sl2 * (float)(64 * t - qpos + 4 * hh) - m_run, tb1 = tb + 32.0f * sl2;
#pragma unroll
            for (int i = 0; i < 16; ++i) { p0[i] = fmaf(sl2, (float)((i & 3) + 8 * (i >> 2)), tb); p1[i] = fmaf(sl2, (float)((i & 3) + 8 * (i >> 2)), tb1); }
#pragma unroll
            for (int ds = 0; ds < 4; ++ds) { const bf16x8 k0 = *(const LAS bf16x8*)(Kst + ds * 2048), k1 = *(const LAS bf16x8*)(Kst + ds * 2048 + 512);
                p0 = ATT_MFMA(k0, qf[ds], p0); p1 = ATT_MFMA(k1, qf[ds], p1); }
            __builtin_amdgcn_sched_barrier(0);
            if (64 * t + 63 > qp0) {
#pragma unroll
                for (int i = 0; i < 16; ++i) { const int kp = 64 * t + crow(i, hh); if (kp > qpos) p0[i] = -INFINITY; if (kp + 32 > qpos) p1[i] = -INFINITY; }
            }
            float mx = fmaxf(p0[0], p1[0]);
#pragma unroll
            for (int i = 1; i < 16; ++i) mx = fmaxf(mx, fmaxf(p0[i], p1[i]));
            mx = swapmax(mx);
            if (__any(mx > ATT_THR)) {
                const float dl = fmaxf(mx, 0.f), alpha = __builtin_amdgcn_exp2f(-dl); m_run += dl; l_run *= alpha;
#pragma unroll
                for (int i = 0; i < 16; ++i) { p0[i] -= dl; p1[i] -= dl; }
#pragma unroll
                for (int e = 0; e < 4; ++e)
#pragma unroll
                    for (int i = 0; i < 16; ++i) o[e][i] *= alpha; }
            float rs = 0.f;
#pragma unroll
            for (int i = 0; i < 16; ++i) { p0[i] = __builtin_amdgcn_exp2f(p0[i]); p1[i] = __builtin_amdgcn_exp2f(p1[i]); rs += p0[i] + p1[i]; }
            l_run += rs;
            u32x4 pf[4];
#pragma unroll
            for (int s = 0; s < 2; ++s) { pf[s] = (u32x4){pkbf(p0[8 * s], p0[8 * s + 1]), pkbf(p0[8 * s + 2], p0[8 * s + 3]), pkbf(p0[8 * s + 4], p0[8 * s + 5]), pkbf(p0[8 * s + 6], p0[8 * s + 7])};
                pf[2 + s] = (u32x4){pkbf(p1[8 * s], p1[8 * s + 1]), pkbf(p1[8 * s + 2], p1[8 * s + 3]), pkbf(p1[8 * s + 4], p1[8 * s + 5]), pkbf(p1[8 * s + 6], p1[8 * s + 7])}; }
            const LAS unsigned char* vb = vlane + sto;
            s16x4 vl[2][4], vh[2][4];
#pragma unroll
            for (int e = 0; e < 4; ++e) { vl[0][e] = vtr(vb + e * 4096); vh[0][e] = vtr(vb + e * 4096 + 512); }
#pragma unroll
            for (int s = 0; s < 4; ++s) {
                if (s < 3) {
#pragma unroll
                    for (int e = 0; e < 4; ++e) { vl[(s + 1) & 1][e] = vtr(vb + e * 4096 + (s + 1) * 1024); vh[(s + 1) & 1][e] = vtr(vb + e * 4096 + (s + 1) * 1024 + 512); } }
#pragma unroll
                for (int e = 0; e < 4; ++e) { const s16x4 lo = vl[s & 1][e], hi = vh[s & 1][e];
                    const bf16x8 vf = (bf16x8){lo[0], lo[1], lo[2], lo[3], hi[0], hi[1], hi[2], hi[3]};
                    o[e] = ATT_MFMA(vf, __builtin_bit_cast(bf16x8, pf[s]), o[e]); }
                __builtin_amdgcn_sched_barrier(0); }
        }
        sto = sto == 2 * ST_BYTES ? 0 : sto + ST_BYTES; stn = stn == 2 * ST_BYTES ? 0 : stn + ST_BYTES;
    }
    asm volatile("s_waitcnt lgkmcnt(0)" ::: "memory"); __builtin_amdgcn_s_barrier(); asm volatile("" ::: "memory");
    const float linv = 1.0f / swapadd(l_run);
    LAS float* CB = (LAS float*)(lds + qs * 16384);
    if (m == 1) { const float f = -A.lam * linv;
#pragma unroll
        for (int e = 0; e < 4; ++e)
#pragma unroll
            for (int i = 0; i < 16; ++i) CB[(32 * e + crow(i, hh)) * 32 + r] = o[e][i] * f; }
    asm volatile("s_waitcnt lgkmcnt(0)" ::: "memory"); __builtin_amdgcn_s_barrier(); asm volatile("" ::: "memory");
    float ss = 0.f;
    if (m == 0) {
#pragma unroll
        for (int e = 0; e < 4; ++e)
#pragma unroll
            for (int i = 0; i < 16; ++i) { const float v = o[e][i] * linv + CB[(32 * e + crow(i, hh)) * 32 + r]; o[e][i] = v; ss += v * v; }
    }
    ss = swapadd(ss);
    asm volatile("s_waitcnt lgkmcnt(0)" ::: "memory"); __builtin_amdgcn_s_barrier(); asm volatile("" ::: "memory");
    LAS unsigned char* OS = lds + qs * 16384;
    if (m == 0) { const float rr = A.one_minus_lam_init / sqrtf(ss * (1.0f / 128.0f) + EPS);
        typedef float f32x2g __attribute__((ext_vector_type(2)));
#pragma unroll
        for (int e = 0; e < 4; ++e) { f32x2g gg[8];
#pragma unroll
            for (int i = 0; i < 16; i += 2) gg[i >> 1] = *(const GAS f32x2g*)(A.gain + 32 * e + crow(i, hh));
#pragma unroll
            for (int i = 0; i < 16; i += 2) { const int ee = 32 * e + crow(i, hh);
                *(LAS unsigned*)(OS + r * 264 + ee * 2) = pkbf(o[e][i] * rr * gg[i >> 1][0], o[e][i + 1] * rr * gg[i >> 1][1]); }
            asm volatile("" ::: "memory"); }
        asm volatile("s_waitcnt lgkmcnt(0)" ::: "memory");
        const int orow0 = b * SEQ + 128 * jb + 32 * qs;
#pragma unroll
        for (int k = 0; k < 8; ++k) { const int idx = k * 64 + lane, row = idx >> 4, ch = idx & 15;
            const unsigned long long lo = *(const LAS unsigned long long*)(OS + row * 264 + ch * 16), hi = *(const LAS unsigned long long*)(OS + row * 264 + ch * 16 + 8);
            u32x4 w; w.x = (unsigned)lo; w.y = (unsigned)(lo >> 32); w.z = (unsigned)hi; w.w = (unsigned)(hi >> 32);
            *(GAS u32x4*)(A.AO + (size_t)(orow0 + row) * D_MODEL + h * 128 + ch * 8) = w; }
    }
    asm volatile("s_waitcnt lgkmcnt(0)" ::: "memory"); __builtin_amdgcn_s_barrier(); asm volatile("" ::: "memory");
}
}
namespace mls {
using namespace cfg;
using att::f32x16; using att::s16x4; using att::u32x4; using att::crow; using att::swapadd; using att::vtr; using att::pkbf; using att::glds16;
constexpr int QI = 0, KI = 65536, VI = 98304, GT = 131072 + 1024;
struct MArgs { const bf16 *MQs, *MKs, *VMs, *OGs; bf16* AO; const float *A2, *C2, *MT, *gain; };

__device__ __forceinline__ void stage_k(const MArgs& A, LAS unsigned char* lds, int rowbase, int t, int h, int wave, int lane) {
#pragma unroll
    for (int i = 0; i < 4; ++i) { const int c = 4 * wave + i; int key = 64 * t + lane; key = key < T ? key : T - 1;
        glds16(A.MKs + (size_t)(rowbase + key) * 1024 + h * 256 + c * 8, lds + KI + c * 1024); }
}
__device__ __forceinline__ void stage_v(const MArgs& A, LAS unsigned char* lds, int rowbase, int t, int h, int wave, int lane) {
#pragma unroll
    for (int i = 0; i < 4; ++i) { const int p = 4 * wave + i, eb = p >> 2, rg = p & 3; int key = 64 * t + 16 * rg + (lane >> 2); key = key < T ? key : T - 1;
        glds16(A.VMs + (size_t)(rowbase + key) * 1024 + h * 256 + eb * 32 + (lane & 3) * 8, lds + VI + p * 1024); }
}

__device__ __forceinline__ void mlstm_unit(const MArgs& A, LAS unsigned char* lds, int b, int h, int jb, int tid, int wave, int lane) {
    const int qs = wave >> 1, eh = wave & 1, r = lane & 31, hh = lane >> 5, bh = b * N_HEADS_M + h;
    const int rowbase = b * T, q0 = N_META + 128 * jb, qp0 = q0 + 32 * qs, qpos = qp0 + r, NT = 2 * jb + 3;
    LAS float* c2s = (LAS float*)(lds + GT);
    for (int k = tid; k < 64 * NT; k += 512) c2s[k] = k < T ? A.C2[(size_t)bh * T + k] : -INFINITY;
    float a2q = A.A2[(size_t)bh * T + qpos], mq = A.MT[(size_t)bh * T + qpos];
    asm volatile("s_waitcnt vmcnt(0) lgkmcnt(0)" : "+v"(a2q), "+v"(mq) :: "memory");
#pragma unroll
    for (int i = 0; i < 8; ++i) { const int p = 8 * wave + i, c = p >> 1, rh = p & 1;
        glds16(A.MQs + (size_t)(rowbase + q0 + 64 * rh + lane) * 1024 + h * 256 + c * 8, lds + QI + c * 2048 + rh * 1024); }
    stage_k(A, lds, rowbase, 0, h, wave, lane); stage_v(A, lds, rowbase, 0, h, wave, lane);
    f32x16 o[4];
#pragma unroll
    for (int e = 0; e < 4; ++e)
#pragma unroll
        for (int i = 0; i < 16; ++i) o[e][i] = 0.f;
    float den = 0.f;
    const LAS unsigned char* qlane = lds + QI + hh * 2048 + (32 * qs + r) * 16;
    const LAS unsigned char* klane = lds + KI + hh * 1024 + r * 16;
    const LAS unsigned char* vlane = lds + VI + eh * 16384 + ((lane >> 4) & 1) * 32 + (lane & 3) * 8 + (4 * hh + ((lane & 15) >> 2)) * 64;
    for (int t = 0; t < NT; ++t) {
        asm volatile("s_waitcnt vmcnt(4)" ::: "memory");
        __builtin_amdgcn_s_barrier(); asm volatile("" ::: "memory");
        const bool act = 64 * t <= qp0 + 31;
        f32x16 p0, p1;
        if (act) {
#pragma unroll
            for (int i = 0; i < 16; ++i) { p0[i] = 0.f; p1[i] = 0.f; }
#pragma unroll
            for (int ds = 0; ds < 16; ++ds) { const bf16x8 qf = *(const LAS bf16x8*)(qlane + ds * 4096), k0 = *(const LAS bf16x8*)(klane + ds * 2048), k1 = *(const LAS bf16x8*)(klane + ds * 2048 + 512);
                p0 = ATT_MFMA(k0, qf, p0); p1 = ATT_MFMA(k1, qf, p1);
                if ((ds & 1) == 1) __builtin_amdgcn_sched_barrier(0); }
        }
        asm volatile("s_waitcnt lgkmcnt(0)" ::: "memory"); __builtin_amdgcn_s_barrier(); asm volatile("" ::: "memory");
        if (t + 1 < NT) stage_k(A, lds, rowbase, t + 1, h, wave, lane);
        u32x4 pf[4];
        if (act) {
            const LAS float* cc = c2s + 64 * t + 4 * hh; const bool diag = 64 * t + 63 > qp0;
#pragma unroll
            for (int g = 0; g < 4; ++g) { const f32x4 c0 = *(const LAS f32x4*)(cc + 8 * g), c1 = *(const LAS f32x4*)(cc + 32 + 8 * g);
#pragma unroll
                for (int j = 0; j < 4; ++j) { const int i = 4 * g + j, kp = 64 * t + crow(i, hh);
                    float w0 = p0[i] * __builtin_amdgcn_exp2f(a2q + c0[j]), w1 = p1[i] * __builtin_amdgcn_exp2f(a2q + c1[j]);
                    if (diag) { if (kp > qpos) w0 = 0.f; if (kp + 32 > qpos) w1 = 0.f; }
                    p0[i] = w0; p1[i] = w1; den += w0 + w1; } }
#pragma unroll
            for (int s = 0; s < 2; ++s) { pf[s] = (u32x4){pkbf(p0[8 * s], p0[8 * s + 1]), pkbf(p0[8 * s + 2], p0[8 * s + 3]), pkbf(p0[8 * s + 4], p0[8 * s + 5]), pkbf(p0[8 * s + 6], p0[8 * s + 7])};
                pf[2 + s] = (u32x4){pkbf(p1[8 * s], p1[8 * s + 1]), pkbf(p1[8 * s + 2], p1[8 * s + 3]), pkbf(p1[8 * s + 4], p1[8 * s + 5]), pkbf(p1[8 * s + 6], p1[8 * s + 7])}; }
        }
        if (t + 1 < NT) asm volatile("s_waitcnt vmcnt(4)" ::: "memory"); else asm volatile("s_waitcnt vmcnt(0)" ::: "memory");
        __builtin_amdgcn_s_barrier(); asm volatile("" ::: "memory");
        if (act) {
#pragma unroll
            for (int s = 0; s < 4; ++s) { __builtin_amdgcn_sched_barrier(0);
#pragma unroll
                for (int e = 0; e < 4; ++e) { const s16x4 lo = vtr(vlane + e * 4096 + s * 1024), hi = vtr(vlane + e * 4096 + s * 1024 + 512);
                    const bf16x8 vf = (bf16x8){lo[0], lo[1], lo[2], lo[3], hi[0], hi[1], hi[2], hi[3]};
                    o[e] = ATT_MFMA(vf, __builtin_bit_cast(bf16x8, pf[s]), o[e]); } }
        }
        asm volatile("s_waitcnt lgkmcnt(0)" ::: "memory"); __builtin_amdgcn_s_barrier(); asm volatile("" ::: "memory");
        if (t + 1 < NT) stage_v(A, lds, rowbase, t + 1, h, wave, lane);
    }
    den = swapadd(den);
    const float dinv = 1.0f / fmaxf(fabsf(den), __expf(-mq));
    float ss = 0.f;
#pragma unroll
    for (int e = 0; e < 4; ++e)
#pragma unroll
        for (int i = 0; i < 16; ++i) { o[e][i] *= dinv; ss += o[e][i] * o[e][i]; }
    ss = swapadd(ss);
    LAS float* XS = (LAS float*)(lds + GT);
    if (hh == 0) XS[wave * 32 + r] = ss;
    asm volatile("s_waitcnt lgkmcnt(0)" ::: "memory"); __builtin_amdgcn_s_barrier(); asm volatile("" ::: "memory");
    ss += XS[(wave ^ 1) * 32 + r];
    const float rr = 1.0f / sqrtf(ss * (1.0f / 256.0f) + EPS);
    LAS unsigned char* OS = lds + wave * 16384;
    typedef float f32x2g __attribute__((ext_vector_type(2)));
#pragma unroll
    for (int e = 0; e < 4; ++e) { f32x2g gg[8];
#pragma unroll
        for (int i = 0; i < 16; i += 2) gg[i >> 1] = *(const GAS f32x2g*)(A.gain + 128 * eh + 32 * e + crow(i, hh));
#pragma unroll
        for (int i = 0; i < 16; i += 2) { const int el = 32 * e + crow(i, hh);
            *(LAS unsigned*)(OS + r * 264 + el * 2) = pkbf(o[e][i] * rr * gg[i >> 1][0], o[e][i + 1] * rr * gg[i >> 1][1]); }
        asm volatile("" ::: "memory"); }
    asm volatile("s_waitcnt lgkmcnt(0)" ::: "memory");
    const int orow0 = b * SEQ + 128 * jb + 32 * qs;
    u32x4 ogv[8];
#pragma unroll
    for (int k = 0; k < 8; ++k) { const int idx = k * 64 + lane, row = idx >> 4, ch = idx & 15; ogv[k] = *(const GAS u32x4*)(A.OGs + (size_t)(rowbase + qp0 + row) * 1024 + h * 256 + eh * 128 + ch * 8); }
#pragma unroll
    for (int k = 0; k < 8; ++k) { const int idx = k * 64 + lane, row = idx >> 4, ch = idx & 15;
        const unsigned long long lo = *(const LAS unsigned long long*)(OS + row * 264 + ch * 16), hi = *(const LAS unsigned long long*)(OS + row * 264 + ch * 16 + 8);
        const u32x4 og = ogv[k];
        const unsigned hv[4] = {(unsigned)lo, (unsigned)(lo >> 32), (unsigned)hi, (unsigned)(hi >> 32)}; u32x4 w;
#pragma unroll
        for (int j = 0; j < 4; ++j) { const float h0 = __uint_as_float(hv[j] << 16), h1 = __uint_as_float(hv[j] & 0xffff0000u), g0 = __uint_as_float(og[j] << 16), g1 = __uint_as_float(og[j] & 0xffff0000u);
            w[j] = pkbf(h0 / (1.0f + __expf(-g0)), h1 / (1.0f + __expf(-g1))); }
        *(GAS u32x4*)(A.AO + (size_t)(orow0 + row) * D_MODEL + MLSTM_WIDTH + h * 256 + eh * 128 + ch * 8) = w; }
    asm volatile("s_waitcnt vmcnt(0) lgkmcnt(0)" ::: "memory"); __builtin_amdgcn_s_barrier(); asm volatile("" ::: "memory");
}

constexpr int CS_K = 0, CS_V = 8192, CS_BYTES = 40960;
__device__ __forceinline__ void cend_stage(const MArgs& A, LAS unsigned char* st, int rowbase, int t, int h, int dq, int wave, int lane) {
    { const int db = wave >> 2, rg = wave & 3; int key = 64 * t + 16 * rg + (lane >> 2); key = key < T ? key : T - 1;
      glds16(A.MKs + (size_t)(rowbase + key) * 1024 + h * 256 + dq * 64 + db * 32 + (lane & 3) * 8, st + CS_K + wave * 1024); }
#pragma unroll
    for (int i = 0; i < 4; ++i) { const int p = 4 * wave + i, eb = p >> 2, rg = p & 3; int key = 64 * t + 16 * rg + (lane >> 2); key = key < T ? key : T - 1;
        glds16(A.VMs + (size_t)(rowbase + key) * 1024 + h * 256 + eb * 32 + (lane & 3) * 8, st + CS_V + p * 1024); }
}
__device__ __forceinline__ void cend_unit(const MArgs& A, const float* BTM, float* outC, float* outN, LAS unsigned char* lds, int b, int h, int dq, int tid, int wave, int lane) {
    const int dsub = wave >> 2, eq = wave & 3, r = lane & 31, hh = lane >> 5, bh = b * N_HEADS_M + h, rowbase = b * T; constexpr int NT = (T + 63) / 64;
    LAS float* c2s = (LAS float*)(lds + GT);
    const float btm = BTM[bh];
    for (int k = tid; k < 64 * NT; k += 512) c2s[k] = k < T ? A.C2[(size_t)bh * T + k] + btm : -INFINITY;
    asm volatile("s_waitcnt vmcnt(0) lgkmcnt(0)" ::: "memory");
    f32x16 o[2], on;
#pragma unroll
    for (int i = 0; i < 16; ++i) { o[0][i] = 0.f; o[1][i] = 0.f; on[i] = 0.f; }
    const bf16x8 ones = (bf16x8){0x3f80, 0x3f80, 0x3f80, 0x3f80, 0x3f80, 0x3f80, 0x3f80, 0x3f80};
    const int tro = ((lane >> 4) & 1) * 32 + (lane & 3) * 8 + (4 * hh + ((lane & 15) >> 2)) * 64;
    cend_stage(A, lds, rowbase, 0, h, dq, wave, lane);
    for (int t = 0; t < NT; ++t) {
        LAS unsigned char* st = lds + (t & 1) * CS_BYTES;
        if (t + 1 < NT) { cend_stage(A, lds + ((t + 1) & 1) * CS_BYTES, rowbase, t + 1, h, dq, wave, lane); asm volatile("s_waitcnt vmcnt(5)" ::: "memory"); }
        else asm volatile("s_waitcnt vmcnt(0)" ::: "memory");
        __builtin_amdgcn_s_barrier(); asm volatile("" ::: "memory");
#pragma unroll
        for (int s = 0; s < 4; ++s) { __builtin_amdgcn_sched_barrier(0);
            const s16x4 klo = vtr(st + CS_K + dsub * 4096 + s * 1024 + tro), khi = vtr(st + CS_K + dsub * 4096 + s * 1024 + 512 + tro);
            const f32x4 w0 = *(const LAS f32x4*)(c2s + 64 * t + 16 * s + 4 * hh), w1 = *(const LAS f32x4*)(c2s + 64 * t + 16 * s + 8 + 4 * hh);
            u32x4 ks;
#pragma unroll
            for (int j = 0; j < 2; ++j) { ks[j] = pkbf(__uint_as_float((unsigned)(unsigned short)klo[2 * j] << 16) * __builtin_amdgcn_exp2f(w0[2 * j]), __uint_as_float((unsigned)(unsigned short)klo[2 * j + 1] << 16) * __builtin_amdgcn_exp2f(w0[2 * j + 1]));
                ks[2 + j] = pkbf(__uint_as_float((unsigned)(unsigned short)khi[2 * j] << 16) * __builtin_amdgcn_exp2f(w1[2 * j]), __uint_as_float((unsigned)(unsigned short)khi[2 * j + 1] << 16) * __builtin_amdgcn_exp2f(w1[2 * j + 1])); }
            const bf16x8 kf = __builtin_bit_cast(bf16x8, ks);
#pragma unroll
            for (int e = 0; e < 2; ++e) { const s16x4 lo = vtr(st + CS_V + (2 * eq + e) * 4096 + s * 1024 + tro), hi = vtr(st + CS_V + (2 * eq + e) * 4096 + s * 1024 + 512 + tro);
                const bf16x8 vf = (bf16x8){lo[0], lo[1], lo[2], lo[3], hi[0], hi[1], hi[2], hi[3]};
                o[e] = ATT_MFMA(kf, vf, o[e]); }
            on = ATT_MFMA(kf, ones, on); }
        asm volatile("s_waitcnt lgkmcnt(0)" ::: "memory"); __builtin_amdgcn_s_barrier(); asm volatile("" ::: "memory");
    }
    const int d0 = dq * 64 + dsub * 32;
#pragma unroll
    for (int e = 0; e < 2; ++e)
#pragma unroll
        for (int i = 0; i < 16; ++i) outC[((size_t)bh * HEAD_DIM_M + d0 + crow(i, hh)) * HEAD_DIM_M + eq * 64 + e * 32 + r] = o[e][i];
    if (eq == 0 && r == 0) {
#pragma unroll
        for (int i = 0; i < 16; ++i) outN[(size_t)bh * HEAD_DIM_M + d0 + crow(i, hh)] = on[i]; }
    asm volatile("s_waitcnt vmcnt(0)" ::: "memory"); __builtin_amdgcn_s_barrier(); asm volatile("" ::: "memory");
}
}
namespace dec {
using namespace cfg;
__device__ __forceinline__ float bfu(unsigned short h) { return __uint_as_float((unsigned)h << 16); }
__device__ __forceinline__ float sigm(float x) { return 1.0f / (1.0f + __expf(-x)); }
__device__ __forceinline__ float logsig(float x) { return fminf(x, 0.f) - log1pf(expf(-fabsf(x))); }
constexpr int NSEQ_ = BATCH * T;
constexpr int NSPLIT = 32, PPS = N_PAGES / NSPLIT;
constexpr int NROW = 2 * DEC_SEQ;
static_assert(NROW == 8 && V_DIM_A == 128 && N_HEADS_A == 8, "decode lane layout");
constexpr size_t PO_FLOATS = (size_t)DEC_BATCH * NSPLIT * N_HEADS_A * NROW * V_DIM_A, PML_FLOATS = (size_t)DEC_BATCH * NSPLIT * N_HEADS_A * NROW * 2;
template <int CTRL> __device__ __forceinline__ float dpp(float x) { return __builtin_bit_cast(float, __builtin_amdgcn_mov_dpp(__builtin_bit_cast(int, x), CTRL, 0xf, 0xf, true)); }
__device__ __forceinline__ float row16_sum(float x) { x += dpp<0xB1>(x); x += dpp<0x4E>(x); x += dpp<0x141>(x); x += dpp<0x128>(x); return x; }
__device__ __forceinline__ float x4_max(float x) { auto s = __builtin_amdgcn_permlane16_swap(__float_as_uint(x), __float_as_uint(x), false, false); x = fmaxf(__uint_as_float(s[0]), __uint_as_float(s[1]));
    auto t = __builtin_amdgcn_permlane32_swap(__float_as_uint(x), __float_as_uint(x), false, false); return fmaxf(__uint_as_float(t[0]), __uint_as_float(t[1])); }
__device__ __forceinline__ float x4_sum(float x) { auto s = __builtin_amdgcn_permlane16_swap(__float_as_uint(x), __float_as_uint(x), false, false); x = __uint_as_float(s[0]) + __uint_as_float(s[1]);
    auto t = __builtin_amdgcn_permlane32_swap(__float_as_uint(x), __float_as_uint(x), false, false); return __uint_as_float(t[0]) + __uint_as_float(t[1]); }
struct DArgs { const float *ck, *cv; const int* pt; const bf16* smp; float *PO, *PML; };
typedef short bf16x8d __attribute__((ext_vector_type(8)));
typedef short s16x4d __attribute__((ext_vector_type(4)));
typedef unsigned u32x2d __attribute__((ext_vector_type(2)));
using att::u32x4;
#define DEC_MFMA(a, b, c) __builtin_amdgcn_mfma_f32_16x16x32_bf16((a), (b), (c), 0, 0, 0)
__device__ __forceinline__ void decode_unit(const DArgs& A, LAS unsigned char* lds, int bd, int sp, int wave, int lane) {
    const int h = wave, i16 = lane & 15, kq = lane >> 4; constexpr int NBLK = PPS * PAGE_SIZE / 32;
    const int row = i16, mrow = row >> 2, qrow = row & 3;
    const float sl2 = exp2f(-8.0f * (float)(h + 1) / (float)N_HEADS_A) * 1.4426950408889634f;
    LAS unsigned char* Kimg = lds + wave * 16384; LAS unsigned char* Vimg = Kimg + 8192;
    bf16x8d qf[4];
#pragma unroll
    for (int ks = 0; ks < 4; ++ks) { const int d0 = 32 * ks + 8 * kq; u32x4 w = (u32x4){0u, 0u, 0u, 0u};
        if (row < NROW && (d0 >> 6) == mrow) w = *(const GAS u32x4*)(A.smp + (size_t)(bd * DEC_SEQ + qrow) * 1024 + h * 128 + d0);
        qf[ks] = __builtin_bit_cast(bf16x8d, w); }
    const int st_k = lane >> 5, st_c = lane & 31;
    const unsigned lane_ob = (unsigned)((st_k * ATT_WIDTH + h * 128 + 4 * st_c) * 4);
    constexpr int N_POOL_ = DEC_BATCH * N_PAGES * 5 / 4; static_assert((long long)N_POOL_ * PAGE_SIZE * ATT_WIDTH * 4 < (1ll << 31), "cache byte offsets fit 31 bits");
    const __amdgpu_buffer_rsrc_t rk = __builtin_amdgcn_make_buffer_rsrc((void*)A.ck, 0, N_POOL_ * PAGE_SIZE * ATT_WIDTH * 4, 0x00020000), rv = __builtin_amdgcn_make_buffer_rsrc((void*)A.cv, 0, N_POOL_ * PAGE_SIZE * ATT_WIDTH * 4, 0x00020000);
    f32x4 kr[16], vr[16];
#define DEC_LOADX(blk, rs, reg, lo_, hi_) do { const int b_ = (blk), pg_ = __builtin_amdgcn_readfirstlane(A.pt[bd * N_PAGES + sp * PPS + (b_ >> 2)]); \
        const int so_ = pg_ * (PAGE_SIZE * ATT_WIDTH * 4) + ((b_ & 3) * 32) * (ATT_WIDTH * 4); \
        _Pragma("unroll") for (int i = (lo_); i < (hi_); ++i) reg[i] = __builtin_bit_cast(f32x4, __builtin_amdgcn_raw_buffer_load_b128((rs), (int)lane_ob, so_ + (2 * i) * (ATT_WIDTH * 4), 2)); } while (0)
    DEC_LOADX(0, rk, kr, 0, 16); DEC_LOADX(0, rv, vr, 0, 16);
    f32x4 o[8];
#pragma unroll
    for (int e = 0; e < 8; ++e) o[e] = (f32x4){0.f, 0.f, 0.f, 0.f};
    float m_run = -1e30f, l_run = 0.f;
    const int kchunk = st_c >> 1, ksub = st_c & 1;
    LAS unsigned char *kwb[4], *vwb[4]; const LAS unsigned char *krb[2], *vrb[8];
#pragma unroll
    for (int j = 0; j < 4; ++j) { const int k7 = 2 * j + st_k; kwb[j] = Kimg + kchunk * 512 + ((k7 ^ (kchunk & 7)) * 16) + ksub * 8; vwb[j] = Vimg + k7 * 256 + ((st_c ^ (4 * k7)) * 8); }
#pragma unroll
    for (int e = 0; e < 2; ++e) krb[e] = Kimg + kq * 512 + ((i16 ^ (4 * e + kq)) * 16);
    { const int ra = 4 * kq + (i16 >> 2), pp = i16 & 3;
#pragma unroll
      for (int et = 0; et < 8; ++et) vrb[et] = Vimg + ra * 256 + (((4 * et + pp) ^ (4 * (ra & 7))) * 8); }
    const LAS unsigned char* kfr = Kimg + kq * 512;
    for (int blk = 0; blk < NBLK; ++blk) {
        asm volatile("s_waitcnt lgkmcnt(0)" ::: "memory");
#pragma unroll
        for (int i = 0; i < 16; ++i) {
            u32x2d kw; kw.x = att::pkbf(kr[i][0], kr[i][1]); kw.y = att::pkbf(kr[i][2], kr[i][3]);
            *(LAS u32x2d*)(kwb[i & 3] + (i >> 2) * 128) = kw; }
        asm volatile("" ::: "memory");
        if (blk + 1 < NBLK) DEC_LOADX(blk + 1, rk, kr, 0, 16);
        asm volatile("" ::: "memory");
        asm volatile("s_waitcnt lgkmcnt(0)" ::: "memory");
        const float kp = (float)(sp * PPS * PAGE_SIZE + blk * 32 + 4 * kq - PAST_LEN - qrow);
        f32x4 p0, p1;
#pragma unroll
        for (int t = 0; t < 4; ++t) { p0[t] = sl2 * (kp + (float)t); p1[t] = sl2 * (kp + (float)(16 + t)); }
#pragma unroll
        for (int ks = 0; ks < 4; ++ks) {
            const bf16x8d k0 = *(const LAS bf16x8d*)(krb[ks & 1] + ks * 2048), k1 = *(const LAS bf16x8d*)(krb[ks & 1] + ks * 2048 + 256);
            p0 = DEC_MFMA(k0, qf[ks], p0); p1 = DEC_MFMA(k1, qf[ks], p1); }
        float mx = fmaxf(fmaxf(fmaxf(p0[0], p0[1]), fmaxf(p0[2], p0[3])), fmaxf(fmaxf(p1[0], p1[1]), fmaxf(p1[2], p1[3])));
        mx = x4_max(mx);
        if (__any(mx > m_run)) { const float mn = fmaxf(m_run, mx), al = __builtin_amdgcn_exp2f(m_run - mn); m_run = mn; l_run *= al;
#pragma unroll
            for (int e = 0; e < 8; ++e) o[e] = o[e] * al; }
#pragma unroll
        for (int t = 0; t < 4; ++t) { p0[t] = __builtin_amdgcn_exp2f(p0[t] - m_run); p1[t] = __builtin_amdgcn_exp2f(p1[t] - m_run); }
        l_run += (p0[0] + p0[1]) + (p0[2] + p0[3]) + (p1[0] + p1[1]) + (p1[2] + p1[3]);
        const u32x4 pw = (u32x4){att::pkbf(p0[0], p0[1]), att::pkbf(p0[2], p0[3]), att::pkbf(p1[0], p1[1]), att::pkbf(p1[2], p1[3])};
        const bf16x8d pf = __builtin_bit_cast(bf16x8d, pw);
        asm volatile("" ::: "memory");
#pragma unroll
        for (int i = 0; i < 16; ++i) {
            u32x2d vw; vw.x = att::pkbf(vr[i][0], vr[i][1]); vw.y = att::pkbf(vr[i][2], vr[i][3]);
            *(LAS u32x2d*)(vwb[i & 3] + (i >> 2) * 2048) = vw; }
        asm volatile("" ::: "memory");
        if (blk + 1 < NBLK) DEC_LOADX(blk + 1, rv, vr, 0, 16);
        asm volatile("" ::: "memory");
        asm volatile("s_waitcnt lgkmcnt(0)" ::: "memory");
        asm volatile("" ::: "memory");
#pragma unroll
        for (int et = 0; et < 8; ++et) {
            const s16x4d lo = __builtin_bit_cast(s16x4d, __builtin_amdgcn_ds_read_tr16_b64_v4i16((LAS att::v4i16_t*)(vrb[et])));
            const s16x4d hi = __builtin_bit_cast(s16x4d, __builtin_amdgcn_ds_read_tr16_b64_v4i16((LAS att::v4i16_t*)(vrb[et] + 4096)));
            const bf16x8d vf = (bf16x8d){lo[0], lo[1], lo[2], lo[3], hi[0], hi[1], hi[2], hi[3]};
            o[et] = DEC_MFMA(vf, pf, o[et]); }
        asm volatile("" ::: "memory");
    }
#undef DEC_LOADX
    const float lt = x4_sum(l_run);
    const __amdgpu_buffer_rsrc_t rpo = __builtin_amdgcn_make_buffer_rsrc((void*)A.PO, 0, (int)(PO_FLOATS * 4), 0x00020000);
    const int ln2 = lane_now(); const int row2 = ln2 & 15, kq2 = ln2 >> 4;
    if (row2 < NROW) { const unsigned ub = (unsigned)(((bd * NSPLIT + sp) * N_HEADS_A + h) * NROW + row2);
#pragma unroll
        for (int et = 0; et < 8; ++et) __builtin_amdgcn_raw_buffer_store_b128(__builtin_bit_cast(u32x4, o[et]), rpo, (int)((ub * V_DIM_A + 16 * et + 4 * kq2) * 4u), 0, 16);
        if (kq2 == 0) { __hip_atomic_store(A.PML + ub * 2, m_run, __ATOMIC_RELAXED, __HIP_MEMORY_SCOPE_AGENT); __hip_atomic_store(A.PML + ub * 2 + 1, lt, __ATOMIC_RELAXED, __HIP_MEMORY_SCOPE_AGENT); } }
}
struct CArgs { const float *PO, *PML; const bf16* smp; bf16* AOs; const float* gain; float lam, oml; };
__device__ __forceinline__ float wsum(float v) { return x4_sum(row16_sum(v)); }
__device__ __forceinline__ void decode_combine(const CArgs& A, int bd, int h, int q, int lane) {
    const float sl2 = exp2f(-8.0f * (float)(h + 1) / (float)N_HEADS_A) * 1.4426950408889634f; constexpr size_t SB = (size_t)R_SAMPLE * 1024;
    static_assert(NSPLIT == 32, "lane-parallel statistics");
    float res0 = 0.f, res1 = 0.f;
#pragma unroll
    for (int m = 0; m < 2; ++m) { const int j = m * DEC_SEQ + q;
        float sn[DEC_SEQ]; const float qd = bfu(A.smp[(size_t)(bd * DEC_SEQ + q) * 1024 + h * 128 + m * 64 + lane]);
#pragma unroll
        for (int t = 0; t < DEC_SEQ; ++t) { const float kd = bfu(A.smp[SB + (size_t)(bd * DEC_SEQ + t) * 1024 + h * 128 + m * 64 + lane]); sn[t] = t <= q ? wsum(qd * kd) + sl2 * (float)(t - q) : -INFINITY; }
        const int sl = lane & 31; const size_t ubl = (((size_t)(bd * NSPLIT + sl)) * N_HEADS_A + h) * NROW + j;
        const float ms = A.PML[ubl * 2], ls = A.PML[ubl * 2 + 1];
        float M = ms;
#pragma unroll
        for (int o = 1; o < 32; o <<= 1) M = fmaxf(M, __shfl_xor(M, o));
#pragma unroll
        for (int t = 0; t < DEC_SEQ; ++t) M = fmaxf(M, sn[t]);
        const float fs = __builtin_amdgcn_exp2f(ms - M); float L = (lane < 32) ? ls * fs : 0.f; L = wsum(L);
        float o0 = 0.f, o1 = 0.f;
#pragma unroll 8
        for (int s = 0; s < NSPLIT; ++s) { const size_t ub = (((size_t)(bd * NSPLIT + s)) * N_HEADS_A + h) * NROW + j; const float f = __shfl(fs, s);
            o0 += A.PO[ub * V_DIM_A + lane] * f; o1 += A.PO[ub * V_DIM_A + 64 + lane] * f; }
#pragma unroll
        for (int t = 0; t < DEC_SEQ; ++t) { const float p = __builtin_amdgcn_exp2f(sn[t] - M); L += p;
            o0 += p * bfu(A.smp[2 * SB + (size_t)(bd * DEC_SEQ + t) * 1024 + h * 128 + lane]); o1 += p * bfu(A.smp[2 * SB + (size_t)(bd * DEC_SEQ + t) * 1024 + h * 128 + 64 + lane]); }
        const float sc = (m ? -A.lam : 1.0f) / L; res0 += o0 * sc; res1 += o1 * sc; }
    const float ss = wsum(res0 * res0 + res1 * res1), rr = A.oml / sqrtf(ss * (1.0f / 128.0f) + EPS);
    bf16* o = A.AOs + (size_t)(bd * DEC_SEQ + q) * D_MODEL + h * 128; o[lane] = (bf16)f2bf(res0 * rr * A.gain[lane]); o[64 + lane] = (bf16)f2bf(res1 * rr * A.gain[64 + lane]);
}
struct SArgs { const float *stC, *stN, *stM, *GATES, *gate_bias, *gain; const bf16* smp; bf16* AOs; float *oC, *oN, *oM; };
__device__ __forceinline__ void sample_mlstm_unit(const SArgs& A, LAS float* sm, int bd, int h, int tid, int wave, int lane) {
    constexpr int L = DEC_SEQ, Dh = HEAD_DIM_M; const int bh = bd * N_HEADS_M + h; constexpr size_t SB = (size_t)R_SAMPLE * 1024;
    LAS float* q_ = sm; LAS float* k_ = sm + L * Dh; LAS float* v_ = sm + 2 * L * Dh; LAS float* wk_ = sm + 3 * L * Dh;
    LAS float* qc_ = sm + 4 * L * Dh;
    LAS float* sc_ = sm + 6 * L * Dh;
    float bb[L], ii[L], mm[L]; const float m0 = A.stM[bh]; { float B = 0.f, m = m0;
#pragma unroll
        for (int t = 0; t < L; ++t) { const float* g = A.GATES + ((size_t)NSEQ_ + bd * L + t) * 8; const float ig = g[h] + A.gate_bias[h], lf = logsig(g[4 + h] + A.gate_bias[N_HEADS_M + h]); B += lf; m = fmaxf(lf + m, ig); bb[t] = B; ii[t] = ig; mm[t] = m; } }
    const float mE = mm[L - 1], bL = bb[L - 1], w_c = __expf(bL + m0 - mE);
    for (int i = tid; i < L * Dh; i += 512) { const int t = i / Dh, d = i % Dh; const size_t o = (size_t)(bd * L + t) * 1024 + h * Dh + d;
        q_[i] = bfu(A.smp[6 * SB + o]); const float kv = bfu(A.smp[7 * SB + o]); k_[i] = kv; v_[i] = bfu(A.smp[4 * SB + o]);
        float ws = 0.f;
#pragma unroll
        for (int s = 0; s < L; ++s) if (s == t) ws = __expf(bL - bb[s] + ii[s] - mE);
        wk_[i] = ws * kv; }
    __syncthreads();
    for (int dIdx = wave; dIdx < L * L + L; dIdx += 8) { float a = 0.f;
        if (dIdx < L * L) { const int t = dIdx / L, s = dIdx % L; for (int d = lane; d < Dh; d += 64) a += q_[t * Dh + d] * k_[s * Dh + d]; }
        else { const int t = dIdx - L * L; for (int d = lane; d < Dh; d += 64) a += q_[t * Dh + d] * A.stN[(size_t)bh * Dh + d]; }
        a = wsum(a); if (lane == 0) sc_[dIdx] = a; }
    { const int e = tid & (Dh - 1), dh = tid >> 8; float qc[L];
#pragma unroll
      for (int t = 0; t < L; ++t) qc[t] = 0.f;
      const float* C0 = A.stC + (size_t)bh * Dh * Dh; float* Co = A.oC + (size_t)bh * Dh * Dh; float ve[L];
#pragma unroll
      for (int s = 0; s < L; ++s) ve[s] = v_[s * Dh + e];
      for (int d = dh * (Dh / 2); d < (dh + 1) * (Dh / 2); ++d) { const float cv = C0[(size_t)d * Dh + e]; float cn = w_c * cv;
#pragma unroll
          for (int t = 0; t < L; ++t) { qc[t] += q_[t * Dh + d] * cv; cn += wk_[t * Dh + d] * ve[t]; }
          Co[(size_t)d * Dh + e] = cn; }
#pragma unroll
      for (int t = 0; t < L; ++t) qc_[(dh * L + t) * Dh + e] = qc[t]; }
    if (tid < Dh) { float nn = w_c * A.stN[(size_t)bh * Dh + tid];
#pragma unroll
        for (int s = 0; s < L; ++s) nn += wk_[s * Dh + tid];
        A.oN[(size_t)bh * Dh + tid] = nn; }
    if (tid == 0) A.oM[bh] = mE;
    __syncthreads();
    { const int e = tid & (Dh - 1), hf = tid >> 8; float hv[2];
#pragma unroll
      for (int u = 0; u < 2; ++u) { const int t = 2 * hf + u; float bt = 0.f, mt = 0.f;
#pragma unroll
          for (int s = 0; s < L; ++s) if (s == t) { bt = bb[s]; mt = mm[s]; }
          const float wi = __expf(bt + m0 - mt); float num = wi * (qc_[t * Dh + e] + qc_[(L + t) * Dh + e]), den = wi * sc_[L * L + t];
#pragma unroll
          for (int s = 0; s < L; ++s) if (s <= t) { const float sv = sc_[t * L + s] * __expf(bt - bb[s] + ii[s] - mt); den += sv; num += sv * v_[s * Dh + e]; }
          hv[u] = num / fmaxf(fabsf(den), __expf(-mt)); }
      LAS float* red = sc_ + L * L + L;
      const float s0 = wsum(hv[0] * hv[0]), s1 = wsum(hv[1] * hv[1]); if (lane == 0) { red[wave * 2] = s0; red[wave * 2 + 1] = s1; }
      __syncthreads();
#pragma unroll
      for (int u = 0; u < 2; ++u) { const int t = 2 * hf + u; float ss = 0.f;
#pragma unroll
          for (int w = 0; w < 4; ++w) ss += red[(hf * 4 + w) * 2 + u];
          const float rr = 1.0f / sqrtf(ss * (1.0f / Dh) + EPS); const size_t o = (size_t)(bd * L + t) * 1024 + h * Dh + e;
          A.AOs[(size_t)(bd * L + t) * D_MODEL + MLSTM_WIDTH + h * Dh + e] = (bf16)f2bf(hv[u] * rr * A.gain[e] * sigm(bfu(A.smp[5 * SB + o]))); } }
    __syncthreads();
}
}
namespace mk {
using namespace cfg;
constexpr int NWAVES = 8, NTHREADS = NWAVES * 64, GRID = 256;
constexpr size_t MiB = 1u << 20;
constexpr size_t FAST_BASE = 0;
constexpr size_t WS_CTL = 0, CTL_ZERO_BYTES = 128 * 1024;
constexpr size_t al_(size_t x) { return (x + 65535) / 65536 * 65536; }
constexpr int NSEQ = BATCH * T;
constexpr size_t WS_WIN = 1 * MiB;
constexpr size_t WS_WOUT = WS_WIN + al_((size_t)6144 * D_MODEL * 2);
constexpr size_t WS_WUP = WS_WOUT + al_((size_t)D_MODEL * D_MODEL * 2);
constexpr size_t WS_WDOWN = WS_WUP + al_((size_t)D_FF * D_MODEL * 2);
constexpr size_t WS_XN = WS_WDOWN + al_((size_t)D_FF * D_MODEL * 2);
constexpr size_t WS_XNS = WS_XN + al_((size_t)R_PROMPT * D_MODEL * 2);
constexpr size_t WS_GATES = WS_XNS + al_((size_t)64 * D_MODEL * 2);
constexpr size_t WS_QS = WS_GATES + al_((size_t)(NSEQ + R_SAMPLE) * 8 * 4);
constexpr size_t SEQB = al_((size_t)NSEQ * 1024 * 2);
constexpr size_t WS_KS = WS_QS + SEQB, WS_VS = WS_KS + SEQB, WS_US = WS_VS + SEQB, WS_VMS = WS_US + SEQB, WS_OGS = WS_VMS + SEQB;
constexpr size_t WS_UAS = WS_OGS + SEQB, WS_MQS = WS_UAS + SEQB, WS_MKS = WS_MQS + SEQB;
constexpr size_t WS_SMP = WS_MKS + SEQB, SMPB = (size_t)R_SAMPLE * 1024 * 2;
constexpr size_t WS_UAT = WS_SMP + al_(8 * SMPB);
constexpr size_t WS_WQK = WS_UAT + al_((size_t)64 * 1024 * 2);
constexpr size_t WS_SCAN = WS_WQK + al_((size_t)N_HEADS_M * 2 * HEAD_DIM_M * HEAD_DIM_M * 2);
constexpr size_t SCANN = (size_t)BATCH * N_HEADS_M * T;
constexpr size_t WS_PO = WS_SCAN + al_((3 * SCANN + 64) * 4);
constexpr size_t WS_PML = WS_PO + al_(dec::PO_FLOATS * 4);
constexpr size_t WS_AOS = WS_PML + al_(dec::PML_FLOATS * 4);
constexpr size_t WS_X1S = WS_AOS + al_((size_t)R_SAMPLE * D_MODEL * 2);
constexpr size_t WS_XN2S = WS_X1S + al_((size_t)R_SAMPLE * D_MODEL * 4);
constexpr size_t WS_SSQS = WS_XN2S + al_((size_t)R_SAMPLE * D_MODEL * 2);
constexpr size_t WS_HS = WS_SSQS + al_((size_t)R_SAMPLE * 128 * 4);
constexpr size_t WS_AO = WS_HS + al_((size_t)R_SAMPLE * D_FF * 2);
constexpr size_t WS_XN2 = WS_AO + al_((size_t)R_PROMPT * D_MODEL * 2);
constexpr size_t WS_H = WS_XN2 + al_((size_t)R_PROMPT * D_MODEL * 2);
constexpr size_t WS_SSQ = WS_H + al_((size_t)R_PROMPT * D_FF * 2);
constexpr size_t WS_FAST_END = WS_SSQ + al_((size_t)R_PROMPT * 8 * 4);
constexpr float QSCALE = 0.125f * 1.4426950408889634f;
constexpr int CW_TMO = 0, CW_BAR = 4096, CW_DECQ = 16384, CW_QKC = CW_DECQ + 64 * 48, CW_DECC = CW_QKC + 64, CW_PQ = CW_DECC + 64;
constexpr int CW_DECQ_ = CW_DECQ;
static_assert((CW_BAR + 2 * 3456) <= CW_DECQ && (CW_PQ + 64) * 4 <= (int)CTL_ZERO_BYTES, "ctl words");
constexpr int RING_OFF = 0, RING_BYTES = 131072, LDSCTL_OFF = RING_BYTES, MISC_OFF = LDSCTL_OFF + 320, LDS_BYTES = 147456;

struct Args {
    const float *x_prompt, *x_sample, *meta, *norm_mix, *w_in, *q_norm, *k_norm, *lambda_qk, *attn_out_norm, *conv_w, *conv_b, *w_qm, *w_km, *gate_bias, *state_conv, *mlstm_out_norm, *cache_k, *cache_v, *state_C, *state_n, *state_m, *w_out, *norm_ffn, *w_up, *w_down, *ao_f32; const int* page_table; float* out; unsigned char* fws;
    int ph_lo, ph_hi, li, pad;
};
struct Frame { LAS unsigned char* lds; volatile LAS unsigned* MISC; int tid, lane, wave, vcu, G; };

__device__ __forceinline__ float wave_sum(float v) { return dec::x4_sum(dec::row16_sum(v)); }
__device__ __forceinline__ void p0_transpose_item(const float* W, int ldw, int K, int N, bf16* WT, LAS float* scr, int item, int lane, float scale = 1.0f) {
    const int nblk = N / 32, kb = item / nblk, nb = item % nblk, k0 = 64 * kb, n0 = 32 * nb;
    { const GAS f32x4* src = (const GAS f32x4*)(W + (size_t)(k0 + lane) * ldw + n0); f32x4 v[8];
#pragma unroll
      for (int i = 0; i < 8; ++i) v[i] = src[i];
#pragma unroll
      for (int i = 0; i < 8; ++i) { scr[lane * 33 + 4 * i] = v[i][0]; scr[lane * 33 + 4 * i + 1] = v[i][1]; scr[lane * 33 + 4 * i + 2] = v[i][2]; scr[lane * 33 + 4 * i + 3] = v[i][3]; } }
    LDS_WAIT(); asm volatile("" ::: "memory");
    const int c = lane & 7;
#pragma unroll
    for (int j = 0; j < 4; ++j) { const int n = (lane >> 3) + 8 * j; const LAS float* s = scr + (8 * c) * 33 + n;
        v4u o; o.x = pk2(s[0 * 33] * scale, s[1 * 33] * scale); o.y = pk2(s[2 * 33] * scale, s[3 * 33] * scale); o.z = pk2(s[4 * 33] * scale, s[5 * 33] * scale); o.w = pk2(s[6 * 33] * scale, s[7 * 33] * scale);
        *(GAS v4u*)(WT + (size_t)(n0 + n) * K + k0 + 8 * c) = o; }
    LDS_WAIT(); asm volatile("" ::: "memory");
}
__device__ __forceinline__ void cvt_rows_bf16(const float* src, bf16* dst, size_t n8, int gw, int NGW, int lane) {
    for (size_t i = (size_t)gw * 64 + lane; i < n8; i += (size_t)NGW * 64) { const f32x4 a = *(const GAS f32x4*)(src + i * 8), b = *(const GAS f32x4*)(src + i * 8 + 4);
        v4u o; o.x = pk2(a[0], a[1]); o.y = pk2(a[2], a[3]); o.z = pk2(b[0], b[1]); o.w = pk2(b[2], b[3]); *(GAS v4u*)(dst + i * 8) = o; }
}

__device__ __forceinline__ void p0_row(const float* x_prompt, const float* x_sample, const float* meta, const f32x4 (&nmix)[8], int r, bf16* XNb, bf16* XNs, float* GATES, const LAS float* WgT, int lane) {
    const float* x = r < R_PROMPT ? x_prompt + (size_t)r * D_MODEL : r < R_FULL ? x_sample + (size_t)(r - R_PROMPT) * D_MODEL : meta + (size_t)(r - R_FULL) * D_MODEL;
    const GAS f32x4* xr = (const GAS f32x4*)x + lane; f32x4 v[8]; float s = 0.f;
#pragma unroll
    for (int j = 0; j < 8; ++j) { v[j] = xr[64 * j]; s += (v[j][0] * v[j][0] + v[j][1] * v[j][1]) + (v[j][2] * v[j][2] + v[j][3] * v[j][3]); }
    const float rstd = 1.0f / sqrtf(wave_sum(s) * (1.0f / D_MODEL) + EPS);
    bf16* orow = r < R_PROMPT ? XNb + (size_t)r * D_MODEL : XNs + (size_t)(r - R_PROMPT) * D_MODEL;
    GAS unsigned long long* o8 = (GAS unsigned long long*)orow + lane;
#pragma unroll
    for (int j = 0; j < 8; ++j) { v[j] = v[j] * rstd * nmix[j];
        o8[64 * j] = (unsigned long long)pk2(v[j][0], v[j][1]) | ((unsigned long long)pk2(v[j][2], v[j][3]) << 32); }
    float ga[8];
#pragma unroll
    for (int g = 0; g < 8; ++g) { float a = 0.f;
#pragma unroll
        for (int j = 0; j < 8; ++j) { const f32x4 w = *(const LAS f32x4*)(WgT + g * D_MODEL + 256 * j + 4 * lane); a += (v[j][0] * w[0] + v[j][1] * w[1]) + (v[j][2] * w[2] + v[j][3] * w[3]); }
        ga[g] = wave_sum(a); asm volatile("" ::: "memory"); }
    float mine = 0.f;
#pragma unroll
    for (int g = 0; g < 8; ++g) mine = (lane & 7) == g ? ga[g] : mine;
    if (r < R_PROMPT) { if (lane < 8) GATES[((size_t)(r / SEQ) * T + N_META + r % SEQ) * 8 + lane] = mine; }
    else if (r < R_FULL) { if (lane < 8) GATES[((size_t)NSEQ + (r - R_PROMPT)) * 8 + lane] = mine; }
    else { if (lane < 8 * BATCH) GATES[((size_t)(lane >> 3) * T + (r - R_FULL)) * 8 + (lane & 7)] = mine; }
}

template <int MT, int NTW, int KS>
__device__ __forceinline__ void skinny_gemm(const bf16* X, int lda, const bf16* Wt, int ldb, int n0, int K, LAS float* red, LAS float* z, int tid, int wave, int lane) {
    static_assert(NTW * KS == NWAVES, "8 waves");
    const int nt = wave % NTW, ks = wave / NTW, kq = lane >> 4, i16 = lane & 15, klen = K / KS, k0 = ks * klen;
    f32x4 acc[MT];
#pragma unroll
    for (int mt = 0; mt < MT; ++mt) acc[mt] = (f32x4){0.f, 0.f, 0.f, 0.f};
    const bf16* wp = Wt + (size_t)(n0 + 16 * nt + i16) * ldb + k0 + 8 * kq;
    const bf16* xp = X + (size_t)i16 * lda + k0 + 8 * kq;
#pragma unroll 8
    for (int k = 0; k < klen; k += 32) {
        const bf16x8 wf = *(const GAS bf16x8*)(wp + k);
#pragma unroll
        for (int mt = 0; mt < MT; ++mt) { const bf16x8 xf = *(const GAS bf16x8*)(xp + (size_t)mt * 16 * lda + k); acc[mt] = __builtin_amdgcn_mfma_f32_16x16x32_bf16(wf, xf, acc[mt], 0, 0, 0); }
    }
#pragma unroll
    for (int mt = 0; mt < MT; ++mt) *(LAS f32x4*)(red + ((ks * NTW + nt) * MT + mt) * 256 + lane * 4) = acc[mt];
    __syncthreads();
    constexpr int ZW = NTW * 16 + 4;
    for (int e = tid; e < MT * 16 * NTW * 16; e += NTHREADS) { const int m = e / (NTW * 16), n = e % (NTW * 16), nt_ = n >> 4, nl = n & 15, mt_ = m >> 4, ml = m & 15; float sum = 0.f;
#pragma unroll
        for (int q = 0; q < KS; ++q) sum += red[((q * NTW + nt_) * MT + mt_) * 256 + (ml + 16 * (nl >> 2)) * 4 + (nl & 3)];
        z[m * ZW + n] = sum; }
    __syncthreads();
}
struct TailBufs { bf16 *Ks, *Vs, *Us, *VMs, *smp; float* out; const float *q_g, *k_g; };
__device__ __forceinline__ void inproj_tail_epi(const TailBufs& B, const LAS float* z, int g, int wave, int lane) {
    const int typ = g >> 4, c = (g & 15) * 64 + lane;
    for (int r = wave; r < 48; r += NWAVES) {
        float v = z[r * 68 + lane];
        if (typ <= 1) { const float ss = wave_sum(v * v); v = v * (1.0f / sqrtf(ss * (1.0f / 64.0f) + EPS)) * (typ ? B.k_g : B.q_g)[lane]; }
        if (r < R_SAMPLE) {
            const int bd = r / DEC_SEQ, ts = r % DEC_SEQ;
            if (typ == 1) B.out[O_KS + (size_t)r * 1024 + c] = v;
            if (typ == 2) B.out[O_VS + (size_t)r * 1024 + c] = v;
            if (typ == 3 && ts >= DEC_SEQ - 3) B.out[O_CVS + ((size_t)bd * 3 + (ts - (DEC_SEQ - 3))) * 1024 + c] = v;
            B.smp[(size_t)typ * (R_SAMPLE * 1024) + (size_t)r * 1024 + c] = (bf16)f2bf(typ == 0 ? v * QSCALE : v);
        } else if (typ >= 1 && typ <= 4) {
            const int t = r - R_SAMPLE; bf16* dst = typ == 1 ? B.Ks : typ == 2 ? B.Vs : typ == 3 ? B.Us : B.VMs; const bf16 hv = (bf16)f2bf(v);
#pragma unroll
            for (int b = 0; b < BATCH; ++b) { const size_t o = ((size_t)b * T + t) * 1024 + c; dst[o] = hv;
                if (typ == 1) B.out[O_KP + o] = v;
                if (typ == 2) B.out[O_VP + o] = v; }
        }
    }
}

__device__ __forceinline__ float bfu(unsigned short h) { return __uint_as_float((unsigned)h << 16); }
__device__ __forceinline__ float sigm(float x) { return 1.0f / (1.0f + __expf(-x)); }
__device__ __forceinline__ float logsig(float x) { return fminf(x, 0.f) - log1pf(expf(-fabsf(x))); }
__device__ __forceinline__ v4u conv_item(const void* const (&rows)[4], const bool (&isf)[4], const float* cw, const float* cb, int c0) {
    float acc[8];
    { const f32x4 b0 = *(const GAS f32x4*)(cb + c0), b1 = *(const GAS f32x4*)(cb + c0 + 4); acc[0] = b0[0]; acc[1] = b0[1]; acc[2] = b0[2]; acc[3] = b0[3]; acc[4] = b1[0]; acc[5] = b1[1]; acc[6] = b1[2]; acc[7] = b1[3]; }
#pragma unroll
    for (int j = 0; j < 4; ++j) if (rows[j]) { float u[8];
        if (isf[j]) { const f32x4 a = *(const GAS f32x4*)rows[j], b = *((const GAS f32x4*)rows[j] + 1); u[0] = a[0]; u[1] = a[1]; u[2] = a[2]; u[3] = a[3]; u[4] = b[0]; u[5] = b[1]; u[6] = b[2]; u[7] = b[3]; }
        else { const v4u a = *(const GAS v4u*)rows[j]; u[0] = __uint_as_float(a.x << 16); u[1] = __uint_as_float(a.x & 0xffff0000u); u[2] = __uint_as_float(a.y << 16); u[3] = __uint_as_float(a.y & 0xffff0000u);
            u[4] = __uint_as_float(a.z << 16); u[5] = __uint_as_float(a.z & 0xffff0000u); u[6] = __uint_as_float(a.w << 16); u[7] = __uint_as_float(a.w & 0xffff0000u); }
        const f32x4 w0 = *(const GAS f32x4*)(cw + j * MLSTM_WIDTH + c0), w1 = *(const GAS f32x4*)(cw + j * MLSTM_WIDTH + c0 + 4);
        acc[0] += u[0] * w0[0]; acc[1] += u[1] * w0[1]; acc[2] += u[2] * w0[2]; acc[3] += u[3] * w0[3]; acc[4] += u[4] * w1[0]; acc[5] += u[5] * w1[1]; acc[6] += u[6] * w1[2]; acc[7] += u[7] * w1[3]; }
#pragma unroll
    for (int i = 0; i < 8; ++i) acc[i] = acc[i] * sigm(acc[i]);
    v4u o; o.x = pk2(acc[0], acc[1]); o.y = pk2(acc[2], acc[3]); o.z = pk2(acc[4], acc[5]); o.w = pk2(acc[6], acc[7]); return o;
}
__device__ __forceinline__ void conv_seg8(const bf16* Us, bf16* dst, const float* cw, const float* cb, int row0, int t0, int c0) {
    v4u uin[11];
#pragma unroll
    for (int k = 0; k < 11; ++k) uin[k] = (t0 - 3 + k >= 0) ? *(const GAS v4u*)(Us + (size_t)(row0 - 3 + k) * 1024 + c0) : (v4u){0u, 0u, 0u, 0u};
    float w[4][8], bias[8];
#pragma unroll
    for (int j = 0; j < 4; ++j) { const f32x4 w0 = *(const GAS f32x4*)(cw + j * MLSTM_WIDTH + c0), w1 = *(const GAS f32x4*)(cw + j * MLSTM_WIDTH + c0 + 4);
        w[j][0] = w0[0]; w[j][1] = w0[1]; w[j][2] = w0[2]; w[j][3] = w0[3]; w[j][4] = w1[0]; w[j][5] = w1[1]; w[j][6] = w1[2]; w[j][7] = w1[3]; }
    { const f32x4 b0 = *(const GAS f32x4*)(cb + c0), b1 = *(const GAS f32x4*)(cb + c0 + 4); bias[0] = b0[0]; bias[1] = b0[1]; bias[2] = b0[2]; bias[3] = b0[3]; bias[4] = b1[0]; bias[5] = b1[1]; bias[6] = b1[2]; bias[7] = b1[3]; }
#pragma unroll
    for (int k = 0; k < 8; ++k) { float acc[8];
#pragma unroll
        for (int i = 0; i < 8; ++i) acc[i] = bias[i];
#pragma unroll
        for (int j = 0; j < 4; ++j) { const v4u u = uin[k + j]; const unsigned uw[4] = {u.x, u.y, u.z, u.w};
#pragma unroll
            for (int i = 0; i < 4; ++i) { acc[2 * i] += __uint_as_float(uw[i] << 16) * w[j][2 * i]; acc[2 * i + 1] += __uint_as_float(uw[i] & 0xffff0000u) * w[j][2 * i + 1]; } }
#pragma unroll
        for (int i = 0; i < 8; ++i) acc[i] = acc[i] * sigm(acc[i]);
        v4u o; o.x = pk2(acc[0], acc[1]); o.y = pk2(acc[2], acc[3]); o.z = pk2(acc[4], acc[5]); o.w = pk2(acc[6], acc[7]);
        *(GAS v4u*)(dst + (size_t)k * 1024 + c0) = o; }
}
__device__ __forceinline__ void handoff_publish(gu32* ctr, int tid) {
    asm volatile("s_waitcnt vmcnt(0)" ::: "memory"); __syncthreads();
    if (tid == 0) __hip_atomic_fetch_add(ctr, 1u, __ATOMIC_RELEASE, __HIP_MEMORY_SCOPE_AGENT);
}
__device__ __forceinline__ void handoff_publish_wt(gu32* ctr, int tid) {
    asm volatile("s_waitcnt vmcnt(0)" ::: "memory"); __syncthreads();
    if (tid == 0) __hip_atomic_fetch_add(ctr, 1u, __ATOMIC_RELAXED, __HIP_MEMORY_SCOPE_AGENT);
}
__device__ __forceinline__ void handoff_wait(gu32* ctr, unsigned need, int tid) {
    if (tid == 0) { int spins = 0; while (__hip_atomic_load(ctr, __ATOMIC_RELAXED, __HIP_MEMORY_SCOPE_AGENT) < need && ++spins < (1 << 20)) __builtin_amdgcn_s_sleep(16);
        __builtin_amdgcn_fence(__ATOMIC_ACQUIRE, "agent"); }
    __syncthreads();
}
__device__ __forceinline__ void gate_scan(const float* GATES, const float* gate_bias, float* SCAN, float* out_m, int bh, int lane) {
    constexpr float LOG2E = 1.4426950408889634f; constexpr int SEG = (T + 63) / 64;
    const int b = bh / N_HEADS_M, h = bh % N_HEADS_M; const float bi = gate_bias[h], bfg = gate_bias[N_HEADS_M + h];
    const int t0 = lane * SEG, t1 = t0 + SEG < T ? t0 + SEG : T; const float* g = GATES + (size_t)b * T * 8;
    float a = 0.f, c = -INFINITY; float gi_[SEG], gf_[SEG];
#pragma unroll
    for (int k = 0; k < SEG; ++k) { const int t = t0 + k < T ? t0 + k : T - 1; gi_[k] = g[t * 8 + h]; gf_[k] = g[t * 8 + 4 + h]; }
#pragma unroll
    for (int k = 0; k < SEG; ++k) { const float ig = gi_[k] + bi, lf = logsig(gf_[k] + bfg); gi_[k] = ig; gf_[k] = lf; if (t0 + k < t1) { a += lf; c = fmaxf(c + lf, ig); } }
    float ia = a, ic = c;
#pragma unroll
    for (int o = 1; o < 64; o <<= 1) { const float pa = __shfl_up(ia, o), pc = __shfl_up(ic, o); if (lane >= o) { ic = fmaxf(pc + ia, ic); ia = pa + ia; } }
    float ea = __shfl_up(ia, 1), ec = __shfl_up(ic, 1); if (lane == 0) { ea = 0.f; ec = -INFINITY; }
    float B = ea, m = fmaxf(ea, ec);
    float* A2 = SCAN + (size_t)bh * T; float* C2 = SCAN + SCANN + (size_t)bh * T; float* MT = SCAN + 2 * SCANN + (size_t)bh * T;
#pragma unroll
    for (int k = 0; k < SEG; ++k) { const int t = t0 + k; if (t < t1) { const float ig = gi_[k], lf = gf_[k]; B += lf; m = fmaxf(lf + m, ig);
        A2[t] = (B - m) * LOG2E; C2[t] = (ig - B) * LOG2E; MT[t] = m;
        if (t == T - 1) { SCAN[3 * SCANN + bh] = (B - m) * LOG2E; out_m[bh] = m; } } }
}
struct QkTail { bf16 *MQs, *MKs, *smp; };
__device__ __forceinline__ void qk_tail_epi(const QkTail& B, const LAS float* z, int gi, int wave, int lane) {
    const int head = gi >> 3, isk = (gi >> 2) & 1, c = head * 256 + (gi & 3) * 64 + lane;
    for (int r = wave; r < 48; r += NWAVES) { const bf16 hv = (bf16)f2bf(z[r * 68 + lane]);
        if (r < R_SAMPLE) B.smp[(size_t)(6 + isk) * (R_SAMPLE * 1024) + (size_t)r * 1024 + c] = hv;
        else { bf16* dst = B.MQs + (size_t)isk * ((WS_MKS - WS_MQS) / 2);
#pragma unroll
            for (int b = 0; b < BATCH; ++b) dst[((size_t)b * T + (r - R_SAMPLE)) * 1024 + c] = hv; } }
}

typedef const Args __attribute__((address_space(4)))* KArgs;
#define PHASE_ARGS KArgs ap = (KArgs)__builtin_amdgcn_kernarg_segment_ptr(); asm volatile("" : "+s"(ap))
__global__ void __launch_bounds__(NTHREADS, 2) mega_fwd(Args args) {
    extern __shared__ __attribute__((aligned(16))) unsigned char lds[];
    Frame F; F.lds = (LAS unsigned char*)lds; F.MISC = (volatile LAS unsigned*)(F.lds + MISC_OFF);
    F.tid = threadIdx.x; F.lane = F.tid & 63; F.wave = __builtin_amdgcn_readfirstlane(F.tid >> 6);
    F.G = gridDim.x; { const int bx = blockIdx.x; F.vcu = (F.G % 8 == 0) ? (bx % 8) * (F.G / 8) + bx / 8 : bx; }
    unsigned char* ws = args.fws;
    gu32* ctl = (gu32*)(ws + WS_CTL);
    for (int u = F.tid; u < (LDS_BYTES - LDSCTL_OFF) / 4; u += NTHREADS) ((LAS unsigned*)(F.lds + LDSCTL_OFF))[u] = 0u;
    __syncthreads();
    XcdBarrier bar = xcd_barrier_post((unsigned*)(ctl + CW_BAR) + args.li * XCD_BAR_WORDS, F.MISC + 8);
    const int lo = args.ph_lo, hi = args.ph_hi;
#ifndef PH_MASK
#define PH_MASK 0xffff
#endif
#define IN(k) (((PH_MASK >> (k)) & 1) && lo <= (k) && (k) < hi)
#define BOTH(k) (IN(k) && IN((k) + 1))
#ifndef DUP_MASK
#define DUP_MASK 0
#endif
#define REP(k) _Pragma("unroll") for (int rep_ = 0; rep_ < (((DUP_MASK >> (k)) & 1) ? 2 : 1); ++rep_)
    bf16* Wout_t = (bf16*)(ws + WS_WOUT); bf16* Wup_t = (bf16*)(ws + WS_WUP); bf16* Wdown_t = (bf16*)(ws + WS_WDOWN);
    bf16* Win_t = (bf16*)(ws + WS_WIN); bf16* XNb = (bf16*)(ws + WS_XN); bf16* XNs = (bf16*)(ws + WS_XNS); float* GATES = (float*)(ws + WS_GATES);
    bf16 *Qs = (bf16*)(ws + WS_QS), *Ks = (bf16*)(ws + WS_KS), *Vs = (bf16*)(ws + WS_VS), *Us = (bf16*)(ws + WS_US), *VMs = (bf16*)(ws + WS_VMS), *OGs = (bf16*)(ws + WS_OGS);
    bf16 *UAs = (bf16*)(ws + WS_UAS), *MQs = (bf16*)(ws + WS_MQS), *MKs = (bf16*)(ws + WS_MKS), *SMP = (bf16*)(ws + WS_SMP), *UAt = (bf16*)(ws + WS_UAT), *Wqk_t = (bf16*)(ws + WS_WQK);
    float* SCAN = (float*)(ws + WS_SCAN); float* PO = (float*)(ws + WS_PO); float* PML = (float*)(ws + WS_PML); bf16* AOs = (bf16*)(ws + WS_AOS);
    float* X1s = (float*)(ws + WS_X1S); bf16* XN2s = (bf16*)(ws + WS_XN2S); float* SSQs = (float*)(ws + WS_SSQS); bf16* Hs = (bf16*)(ws + WS_HS);
    bf16* AO = (bf16*)(ws + WS_AO); bf16* XN2 = (bf16*)(ws + WS_XN2); bf16* H = (bf16*)(ws + WS_H); float* SSQ = (float*)(ws + WS_SSQ);
    float* X1 = args.out + O_Y;

    if (IN(0)) REP(0) { PHASE_ARGS;
        LAS float* scr = (LAS float*)(F.lds + RING_OFF + F.wave * 16384);
        const int gw = F.vcu * NWAVES + F.wave, NGW = F.G * NWAVES;
        constexpr int I_I = (D_MODEL / 64) * (6144 / 32), I_O = (D_MODEL / 64) * (D_MODEL / 32), I_U = (D_MODEL / 64) * (D_FF / 32), I_D = (D_FF / 64) * (D_MODEL / 32), I_M = (HEAD_DIM_M / 64) * (HEAD_DIM_M / 32);
        static_assert(HEAD_DIM_M == 256, "k scale 1/16");
        for (int it = gw; it < I_I + 2 * N_HEADS_M * I_M; it += NGW) {
            int r = it;
            if (r < I_I) { p0_transpose_item(ap->w_in, PROJ_WIDTH, D_MODEL, 6144, Win_t, scr, r, F.lane); continue; } r -= I_I;
            { const int hm = r / I_M, ri = r % I_M, hd = hm >> 1, isk = hm & 1;
              p0_transpose_item((isk ? ap->w_km : ap->w_qm) + (size_t)hd * HEAD_DIM_M * HEAD_DIM_M, HEAD_DIM_M, HEAD_DIM_M, HEAD_DIM_M, Wqk_t + ((size_t)hd * 2 + isk) * HEAD_DIM_M * HEAD_DIM_M, scr, ri, F.lane, isk ? 0.0625f : 1.0f); }
        }
        __syncthreads();
        LAS float* WgT = (LAS float*)(F.lds + RING_OFF);
        { f32x4 ga[D_MODEL / NTHREADS], gb[D_MODEL / NTHREADS];
#pragma unroll
          for (int j = 0; j < D_MODEL / NTHREADS; ++j) { const float* gp = ap->w_in + (size_t)(F.tid + NTHREADS * j) * PROJ_WIDTH + 6144; ga[j] = *(const GAS f32x4*)gp; gb[j] = *(const GAS f32x4*)(gp + 4); }
#pragma unroll
          for (int j = 0; j < D_MODEL / NTHREADS; ++j) { const int k = F.tid + NTHREADS * j;
#pragma unroll
              for (int g = 0; g < 4; ++g) { WgT[g * D_MODEL + k] = ga[j][g]; WgT[(4 + g) * D_MODEL + k] = gb[j][g]; } } }
        __syncthreads();
        { f32x4 nmix[8];
#pragma unroll
          for (int j = 0; j < 8; ++j) nmix[j] = *((const GAS f32x4*)ap->norm_mix + F.lane + 64 * j);
          for (int r = gw; r < R_ALL; r += NGW) p0_row(ap->x_prompt, ap->x_sample, ap->meta, nmix, r, XNb, XNs, GATES, WgT, F.lane); }
        for (int i = gw * 64 + F.lane; i < 16 * D_MODEL / 8; i += NGW * 64) *(GAS v4u*)(XNs + (size_t)48 * D_MODEL + (size_t)i * 8) = (v4u){0u, 0u, 0u, 0u};
        __syncthreads();
        if (BOTH(0)) xcd_barrier(bar, F.wave);
    }
    if (IN(1)) REP(1) { PHASE_ARGS; F.lane = lane_now(); F.tid = F.wave * 64 + F.lane;
        { LAS float* red = (LAS float*)(F.lds + RING_OFF); LAS float* z = red + 2 * 4 * 3 * 256;
          const TailBufs TB{Ks, Vs, Us, VMs, (bf16*)(ws + WS_SMP), ap->out, ap->q_norm, ap->k_norm};
          for (int gi = (int)blockIdx.x; gi < 6144 / 64; gi += F.G) { skinny_gemm<3, 4, 2>(XNs, D_MODEL, Win_t, D_MODEL, gi * 64, D_MODEL, red, z, F.tid, F.wave, F.lane); inproj_tail_epi(TB, z, gi, F.wave, F.lane); __syncthreads(); } }
        xcd_barrier(bar, F.wave);
        pg8::Gemm g{XNb, Win_t, R_PROMPT, 6144, D_MODEL, D_MODEL, D_MODEL, 0, 0, 0, 0};
        pg8::EpiInProj E{Qs, Ks, Vs, Us, VMs, OGs, ap->out + O_KP, ap->out + O_VP, ap->out + O_CVP, ap->q_norm, ap->k_norm, QSCALE, T, SEQ, N_META};
        const int bx_ = (int)blockIdx.x, q_ = bx_ >> 3, role = ((q_ & 3) == 3) ? 1 : 0, ridx = role ? (q_ >> 2) * 8 + (bx_ & 7) : ((q_ >> 2) * 3 + (q_ & 3)) * 8 + (bx_ & 7);
        if (role == 0) { pg8::RangeOrder S; S.b.init(R_PROMPT, 6144, F.G * 3 / 4, ridx); S.lo = 0; S.hi = 1 << 20;
            pg8::gemm_phase<pg8::EpiInProj, pg8::RangeOrder, true, true>(F.lds + RING_OFF, g, S, E, F.wave); }
        else { const dec::DArgs DA{ap->cache_k, ap->cache_v, ap->page_table, SMP, PO, PML};
            for (int u = 2 * ridx; u < 2 * ridx + 2; ++u) { dec::decode_unit(DA, F.lds + RING_OFF, u / dec::NSPLIT, u % dec::NSPLIT, F.wave, F.lane); handoff_publish_wt(ctl + CW_DECC, F.tid); } }
        if (BOTH(1)) xcd_barrier(bar, F.wave);
    }
    if (IN(4)) REP(4) { PHASE_ARGS; F.lane = lane_now(); F.tid = F.wave * 64 + F.lane;
        float lam; { const float* lq = ap->lambda_qk; float a = lq[F.lane] * lq[64 + F.lane], c = lq[128 + F.lane] * lq[192 + F.lane]; a = wave_sum(a); c = wave_sum(c); lam = expf(a) - expf(c) + LAM_INIT; lam = __uint_as_float((unsigned)__builtin_amdgcn_readfirstlane((int)__float_as_uint(lam))); }
        constexpr int NA = BATCH * N_HEADS_A, NM = BATCH * N_HEADS_M, NXQ = 8, LA = NA / NXQ, LM = NM / NXQ, NDQ = DEC_BATCH * dec::NSPLIT / 2, LD = NDQ / NXQ / 8, LBIG = 8 * (LA + LM + LD) + 8 * (LA + LM), LCEND = LM * 4, LSM = DEC_BATCH * N_HEADS_M / NXQ, LCONV = 128, CONV_ITEMS = 18, LCOMB = DEC_BATCH * N_HEADS_A * DEC_SEQ / (NXQ * NWAVES),
            LQK = (R_PROMPT / 256) * N_HEADS_M / NXQ, LQT = 2 * MLSTM_WIDTH / 64 / NXQ, LSC = NM / NXQ, LPRE = LQK + LQT + LSC, NPROD = NXQ * LPRE, NLOC = LPRE + LBIG + LCEND + LSM + LCONV + LCOMB;
        static_assert((R_PROMPT / 256) * N_HEADS_M % NXQ == 0 && (2 * MLSTM_WIDTH / 64) % NXQ == 0, "producer lists");
        static_assert(NDQ == NXQ * 8 * LD && DEC_BATCH * dec::NSPLIT == 256, "decode units: 128 in the in-projection phase, 128 on the first eight levels of the queue");
        static_assert(NA % NXQ == 0 && NM % NXQ == 0 && (DEC_BATCH * N_HEADS_M) % NXQ == 0, "XCD-local lists");
        static_assert(NPROD <= 256, "one producer grab per workgroup covers the list");
        int xq = (int)(bar.x % NXQ), tries = 0; bool pstage = true;
        for (;;) {
            const int qoff = pstage ? CW_PQ + 16 * rep_ : CW_DECQ + 64 * (1 + xq + 16 * rep_);
            __syncthreads(); if (F.tid == 0) F.MISC[16] = __hip_atomic_fetch_add(ctl + qoff, 1u, RLX_AGENT); __syncthreads();
            const int g_ = (int)F.MISC[16]; int xu, idx0;
            if (pstage) { pstage = false; if (g_ >= NPROD) continue; xu = g_ / LPRE; idx0 = g_ % LPRE; }
            else { if (g_ >= NLOC - LPRE) { if (++tries >= NXQ) break; xq = (xq + 1) % NXQ; continue; } xu = xq; idx0 = g_ + LPRE; }
            F.lane = lane_now(); F.tid = F.wave * 64 + F.lane;
            unsigned char* w2 = ws; asm volatile("" : "+s"(w2));
            const int idx = idx0 - LPRE;
            if (idx0 < LQK) {
                const int pu = xu * LQK + idx0, pm = pu >> 2, h = pu & 3, srow0 = pm * 256 + (pm / (SEQ / 256) + 1) * N_META; bf16* uas = (bf16*)(w2 + WS_UAS);
                for (int it = F.tid; it < 32 * 32; it += NTHREADS) { const int row0 = srow0 + (it >> 5) * 8, c0 = h * HEAD_DIM_M + (it & 31) * 8;
                    conv_seg8((const bf16*)(w2 + WS_US), uas + (size_t)row0 * 1024, ap->conv_w, ap->conv_b, row0, row0 % T, c0); }
                asm volatile("s_waitcnt vmcnt(0)" ::: "memory"); __syncthreads();
                const pg8::Gemm g{uas, (bf16*)(w2 + WS_WQK), R_PROMPT, 2 * MLSTM_WIDTH, HEAD_DIM_M, MLSTM_WIDTH, HEAD_DIM_M, SEQ / 256, N_META, 2, HEAD_DIM_M}; const pg8::PairOrder S{pm, 2 * h};
                const pg8::EpiQKwt E{(bf16*)(w2 + WS_MQS), (long long)((WS_MKS - WS_MQS) / 2), T, SEQ, N_META, (int)SEQB};
                pg8::gemm_phase<pg8::EpiQKwt, pg8::PairOrder, true, true>(F.lds + RING_OFF, g, S, E, F.wave);
                handoff_publish_wt(ctl + CW_QKC, F.tid); }
            else if (idx0 < LQK + LQT) {
                const int gi = xu * LQT + (idx0 - LQK), hh = gi >> 3; bf16* uat = (bf16*)(w2 + WS_UAT); const bf16* smp = (const bf16*)(w2 + WS_SMP);
                for (int it = F.tid; it < 64 * 32; it += NTHREADS) { const int row = it >> 5, c0 = hh * HEAD_DIM_M + (it & 31) * 8;
                    if (row < R_SAMPLE) { const int bd = row / DEC_SEQ, ts = row % DEC_SEQ; const void* rows[4]; bool isf[4] = {false, false, false, false};
#pragma unroll
                        for (int j = 0; j < 4; ++j) { const int tt = ts - 3 + j; isf[j] = tt < 0;
                            rows[j] = tt >= 0 ? (const void*)(smp + 3 * (size_t)(R_SAMPLE * 1024) + (size_t)(bd * DEC_SEQ + tt) * 1024 + c0) : (const void*)(ap->state_conv + ((size_t)bd * 3 + (tt + 3)) * MLSTM_WIDTH + c0); }
                        *(GAS v4u*)(uat + (size_t)row * 1024 + c0) = conv_item(rows, isf, ap->conv_w, ap->conv_b, c0); }
                    else if (row < R_SAMPLE + N_META / 8) { const int r0 = (row - R_SAMPLE) * 8; conv_seg8((const bf16*)(w2 + WS_US), uat + (size_t)(R_SAMPLE + r0) * 1024, ap->conv_w, ap->conv_b, r0, r0, c0); }
                    else if (row >= 48) *(GAS v4u*)(uat + (size_t)row * 1024 + c0) = (v4u){0u, 0u, 0u, 0u}; }
                asm volatile("s_waitcnt vmcnt(0)" ::: "memory"); __syncthreads();
                LAS float* red = (LAS float*)(F.lds + RING_OFF); LAS float* z = red + 2 * 4 * 3 * 256; const QkTail QT{(bf16*)(w2 + WS_MQS), (bf16*)(w2 + WS_MKS), (bf16*)(w2 + WS_SMP)};
                skinny_gemm<3, 4, 2>(uat + hh * HEAD_DIM_M, MLSTM_WIDTH, (bf16*)(w2 + WS_WQK), HEAD_DIM_M, gi * 64, HEAD_DIM_M, red, z, F.tid, F.wave, F.lane); qk_tail_epi(QT, z, gi, F.wave, F.lane);
                handoff_publish(ctl + CW_QKC, F.tid); }
            else if (idx0 < LPRE) {
                const int bh = xu * LSC + (idx0 - LQK - LQT);
                if (F.wave == 0) gate_scan((float*)(w2 + WS_GATES), ap->gate_bias, (float*)(w2 + WS_SCAN), ap->out + O_MP, bh, F.lane);
                handoff_publish(ctl + CW_QKC, F.tid); }
            else if (idx < LBIG) { constexpr int L8 = 8 * (LA + LM + LD); const int lev = idx < L8 ? idx / (LA + LM + LD) : 8 + (idx - L8) / (LA + LM), w = idx < L8 ? idx % (LA + LM + LD) : (idx - L8) % (LA + LM), jb = 15 - lev;
                if (w >= LA + LM) {
                    const int u = NDQ + (xu * 8 + lev) * LD + (w - LA - LM); const dec::DArgs DA{ap->cache_k, ap->cache_v, ap->page_table, (bf16*)(w2 + WS_SMP), (float*)(w2 + WS_PO), (float*)(w2 + WS_PML)};
                    dec::decode_unit(DA, F.lds + RING_OFF, u / dec::NSPLIT, u % dec::NSPLIT, F.wave, F.lane);
                    handoff_publish_wt(ctl + CW_DECC, F.tid); }
                else
                if (w < LA) { const int bh = xu * LA + w; const att::AttnArgs AA{(bf16*)(w2 + WS_QS), (bf16*)(w2 + WS_KS), (bf16*)(w2 + WS_VS), (bf16*)(w2 + WS_AO), ap->attn_out_norm, lam, 1.0f - LAM_INIT};
                    att::attn_unit(AA, F.lds + RING_OFF, bh / N_HEADS_A, bh % N_HEADS_A, jb, F.tid, F.wave, F.lane); }
                else { handoff_wait(ctl + CW_QKC, NPROD, F.tid); const int bh = xu * LM + (w - LA); float* sc = (float*)(w2 + WS_SCAN); const mls::MArgs MA{(bf16*)(w2 + WS_MQS), (bf16*)(w2 + WS_MKS), (bf16*)(w2 + WS_VMS), (bf16*)(w2 + WS_OGS), (bf16*)(w2 + WS_AO), sc, sc + SCANN, sc + 2 * SCANN, ap->mlstm_out_norm};
                    mls::mlstm_unit(MA, F.lds, bh / N_HEADS_M, bh % N_HEADS_M, jb, F.tid, F.wave, F.lane); } }
            else if (idx < LBIG + LCEND) { handoff_wait(ctl + CW_QKC, NPROD, F.tid); const int i = idx - LBIG, bh = xu * LM + (i >> 2); float* sc = (float*)(w2 + WS_SCAN);
                const mls::MArgs MA{(bf16*)(w2 + WS_MQS), (bf16*)(w2 + WS_MKS), (bf16*)(w2 + WS_VMS), (bf16*)(w2 + WS_OGS), (bf16*)(w2 + WS_AO), sc, sc + SCANN, sc + 2 * SCANN, ap->mlstm_out_norm};
                mls::cend_unit(MA, sc + 3 * SCANN, ap->out + O_CP, ap->out + O_NP, F.lds, bh / N_HEADS_M, bh % N_HEADS_M, i & 3, F.tid, F.wave, F.lane); }
            else if (idx >= LBIG + LCEND + LSM + LCONV) {
                handoff_wait(ctl + CW_DECC, DEC_BATCH * dec::NSPLIT, F.tid); const int lc_ = lane_now();
                const int i = (xu * LCOMB + (idx - LBIG - LCEND - LSM - LCONV)) * NWAVES + F.wave;
                const dec::CArgs CA{(float*)(w2 + WS_PO), (float*)(w2 + WS_PML), (bf16*)(w2 + WS_SMP), (bf16*)(w2 + WS_AOS), ap->attn_out_norm, lam, 1.0f - LAM_INIT};
                dec::decode_combine(CA, i / (N_HEADS_A * DEC_SEQ), (i / DEC_SEQ) % N_HEADS_A, i % DEC_SEQ, lc_); }
            else if (idx >= LBIG + LCEND + LSM) {
                constexpr int I_O = (D_MODEL / 64) * (D_MODEL / 32), I_U = (D_MODEL / 64) * (D_FF / 32), I_D = (D_FF / 64) * (D_MODEL / 32);
                static_assert(I_O + I_U + I_D == NXQ * LCONV * CONV_ITEMS, "conversion units");
                const int ln_ = lane_now();
                LAS float* scr = (LAS float*)(F.lds + RING_OFF + F.wave * 16384); const int cu = xu * LCONV + (idx - LBIG - LCEND - LSM);
                for (int it = cu * CONV_ITEMS + F.wave; it < (cu + 1) * CONV_ITEMS; it += NWAVES) { int r = it;
                    if (r < I_O) { p0_transpose_item(ap->w_out, D_MODEL, D_MODEL, D_MODEL, (bf16*)(w2 + WS_WOUT), scr, r, ln_); continue; } r -= I_O;
                    if (r < I_U) { p0_transpose_item(ap->w_up, D_FF, D_MODEL, D_FF, (bf16*)(w2 + WS_WUP), scr, r, ln_); continue; } r -= I_U;
                    p0_transpose_item(ap->w_down, D_MODEL, D_FF, D_MODEL, (bf16*)(w2 + WS_WDOWN), scr, r, ln_); } }
            else { handoff_wait(ctl + CW_QKC, NPROD, F.tid); const int i = xu * LSM + (idx - LBIG - LCEND); const dec::SArgs SA{ap->state_C, ap->state_n, ap->state_m, (float*)(w2 + WS_GATES), ap->gate_bias, ap->mlstm_out_norm, (bf16*)(w2 + WS_SMP), (bf16*)(w2 + WS_AOS), ap->out + O_CS, ap->out + O_NS, ap->out + O_MS};
                dec::sample_mlstm_unit(SA, (LAS float*)(F.lds + RING_OFF), i / N_HEADS_M, i % N_HEADS_M, F.tid, F.wave, F.lane); }
        }
        if (BOTH(4)) xcd_barrier(bar, F.wave);
    }
    if (IN(5)) REP(5) { PHASE_ARGS; F.lane = lane_now(); F.tid = F.wave * 64 + F.lane;
        pg8::Gemm g{AO, Wout_t, R_PROMPT, D_MODEL, D_MODEL, D_MODEL, D_MODEL, 0, 0, 0, 0}; pg8::StaticOrder S; S.init(R_PROMPT, D_MODEL, F.G, (int)blockIdx.x);
        pg8::EpiOutProj E{ap->x_prompt, X1, XN2, ap->norm_ffn, SSQ, D_MODEL};
        pg8::gemm_phase<pg8::EpiOutProj, pg8::StaticOrder, false, true>(F.lds + RING_OFF, g, S, E, F.wave);
        {
            LAS float* red = (LAS float*)(F.lds + RING_OFF); LAS float* z = red + 8 * 1 * 2 * 256;
            for (int nt = (int)blockIdx.x; nt < D_MODEL / 16; nt += F.G) { skinny_gemm<2, 1, 8>(AOs, D_MODEL, Wout_t, D_MODEL, nt * 16, D_MODEL, red, z, F.tid, F.wave, F.lane);
                const int row = F.tid >> 4, col = nt * 16 + (F.tid & 15); const float x1 = ap->x_sample[(size_t)row * D_MODEL + col] + z[row * 20 + (F.tid & 15)];
                X1s[(size_t)row * D_MODEL + col] = x1; XN2s[(size_t)row * D_MODEL + col] = (bf16)f2bf(x1 * ap->norm_ffn[col]);
                const float ss = dec::row16_sum(x1 * x1); if ((F.tid & 15) == 0) SSQs[row * 128 + nt] = ss;
                __syncthreads(); } }
        if (BOTH(5)) xcd_barrier(bar, F.wave);
    }
    if (IN(6)) REP(6) { PHASE_ARGS; F.lane = lane_now(); F.tid = F.wave * 64 + F.lane;
        pg8::Gemm g{XN2, Wup_t, R_PROMPT, D_FF, D_MODEL, D_MODEL, D_MODEL, 0, 0, 0, 0}; pg8::StaticOrder S; S.init(R_PROMPT, D_FF, F.G, (int)blockIdx.x);
        pg8::EpiUp E{H, D_FF, SSQ, 1.0f / (float)D_MODEL};
        pg8::gemm_phase<pg8::EpiUp, pg8::StaticOrder, true, true>(F.lds + RING_OFF, g, S, E, F.wave);
        {
            LAS float* red = (LAS float*)(F.lds + RING_OFF); LAS float* z = red + 4 * 2 * 2 * 256;
            for (int u = (int)blockIdx.x; u < D_FF / 32; u += F.G) { skinny_gemm<2, 2, 4>(XN2s, D_MODEL, Wup_t, D_MODEL, u * 32, D_MODEL, red, z, F.tid, F.wave, F.lane);
                const int row = F.tid >> 4, part = F.tid & 15; float ps = 0.f;
#pragma unroll
                for (int k = 0; k < 8; ++k) ps += SSQs[row * 128 + part * 8 + k];
                const float rstd = 1.0f / sqrtf(dec::row16_sum(ps) * (1.0f / D_MODEL) + EPS);
#pragma unroll
                for (int k = 0; k < 2; ++k) { const int cl = part * 2 + k; float v = z[row * 36 + cl] * rstd; v = v > 0.f ? v * v : 0.f; Hs[(size_t)row * D_FF + u * 32 + cl] = (bf16)f2bf(v); }
                __syncthreads(); } }
        if (BOTH(6)) xcd_barrier(bar, F.wave);
    }
    if (IN(7)) { PHASE_ARGS; F.lane = lane_now(); F.tid = F.wave * 64 + F.lane;
        pg8::Gemm g{H, Wdown_t, R_PROMPT, D_MODEL, D_FF, D_FF, D_FF, 0, 0, 0, 0}; pg8::StaticOrder S; S.init(R_PROMPT, D_MODEL, F.G, (int)blockIdx.x);
        pg8::EpiDown E{X1, X1, D_MODEL};
        pg8::gemm_phase<pg8::EpiDown, pg8::StaticOrder, false, true>(F.lds + RING_OFF, g, S, E, F.wave);
        {
            LAS float* red = (LAS float*)(F.lds + RING_OFF); LAS float* z = red + 8 * 1 * 2 * 256;
            for (int nt = (int)blockIdx.x; nt < D_MODEL / 16; nt += F.G) { skinny_gemm<2, 1, 8>(Hs, D_FF, Wdown_t, D_FF, nt * 16, D_FF, red, z, F.tid, F.wave, F.lane);
                const int row = F.tid >> 4, col = nt * 16 + (F.tid & 15); ap->out[O_YS + (size_t)row * D_MODEL + col] = X1s[(size_t)row * D_MODEL + col] + z[row * 20 + (F.tid & 15)];
                __syncthreads(); }
        }
    }
#undef IN
#undef BOTH
}
}

extern "C" void kernel_launch(void* const* d_in, const int* in_sizes, int n_in, void* d_out, int out_size, void* d_ws, size_t ws_size, hipStream_t stream) {
    static int ready = 0;
    if (!ready) {
        if (ws_size < mk::FAST_BASE + mk::WS_FAST_END || out_size != (int)cfg::O_END || n_in != 26) { fprintf(stderr, "kernel_launch: unexpected sizes (ws %zu, out %d, n_in %d)\n", ws_size, out_size, n_in); ready = -1; return; }
        if (hipFuncSetAttribute((const void*)mk::mega_fwd, hipFuncAttributeMaxDynamicSharedMemorySize, mk::LDS_BYTES) != hipSuccess) { fprintf(stderr, "kernel_launch: hipFuncSetAttribute failed\n"); ready = -1; return; }
        ready = 1;
    }
    if (ready < 0) return;
    unsigned char* fws = (unsigned char*)d_ws + mk::FAST_BASE;
    (void)hipMemsetAsync(fws + mk::WS_CTL, 0, mk::CTL_ZERO_BYTES, stream);
    auto F32 = [&](int i) { return (const float*)d_in[i]; };
    mk::Args a{}; a.x_prompt = F32(0); a.x_sample = F32(1); a.cache_k = F32(2); a.cache_v = F32(3); a.state_C = F32(4); a.state_n = F32(5); a.state_m = F32(6); a.state_conv = F32(7);
    a.page_table = (const int*)d_in[8]; a.meta = F32(9); a.norm_mix = F32(10); a.w_in = F32(11); a.q_norm = F32(12); a.k_norm = F32(13); a.lambda_qk = F32(14); a.attn_out_norm = F32(15);
    a.conv_w = F32(16); a.conv_b = F32(17); a.w_qm = F32(18); a.w_km = F32(19); a.gate_bias = F32(20); a.mlstm_out_norm = F32(21); a.w_out = F32(22); a.norm_ffn = F32(23); a.w_up = F32(24); a.w_down = F32(25);
    a.ao_f32 = nullptr; a.out = (float*)d_out; a.fws = fws; a.ph_lo = 0; a.ph_hi = 8; a.li = 0;
    hipLaunchKernelGGL(mk::mega_fwd, dim3(mk::GRID), dim3(mk::NTHREADS), mk::LDS_BYTES, stream, a);
}
```

```cpp
#include <hip/hip_runtime.h>
#include <cstdio>
#include <cstdint>
#include <math.h>
namespace cfg {
#ifdef SMALL_CFG
constexpr int D_MODEL = 128, BATCH = 2, SEQ = 256, DEC_BATCH = 2, DEC_SEQ = 4, PAST_LEN = 256, PAGE_SIZE = 32, N_META = 16, HEAD_DIM_A = 16, N_HEADS_M = 2;
#else
constexpr int D_MODEL = 2048, BATCH = 4, SEQ = 2048, DEC_BATCH = 8, DEC_SEQ = 4, PAST_LEN = 16384, PAGE_SIZE = 128, N_META = 16, HEAD_DIM_A = 64, N_HEADS_M = 4;
#endif
constexpr int ATT_WIDTH = D_MODEL / 2, V_DIM_A = 2 * HEAD_DIM_A, N_HEADS_A = ATT_WIDTH / V_DIM_A;
constexpr int MLSTM_WIDTH = D_MODEL - ATT_WIDTH, HEAD_DIM_M = MLSTM_WIDTH / N_HEADS_M, CONV_W = 4, D_FF = 4 * D_MODEL;
constexpr int PROJ_WIDTH = 3 * ATT_WIDTH + 3 * MLSTM_WIDTH + 2 * N_HEADS_M;
constexpr int T = SEQ + N_META;
constexpr int N_PAGES = PAST_LEN / PAGE_SIZE;
constexpr int TK_S = PAST_LEN + DEC_SEQ;
constexpr float EPS = 1e-6f;
constexpr float LAM_INIT = 0.2f;
constexpr int R_PROMPT = BATCH * SEQ, R_SAMPLE = DEC_BATCH * DEC_SEQ, R_FULL = R_PROMPT + R_SAMPLE, R_ALL = R_FULL + N_META;
constexpr int ZQ = 0, ZK = ATT_WIDTH, ZV = 2 * ATT_WIDTH, ZU = 3 * ATT_WIDTH, ZVM = ZU + MLSTM_WIDTH, ZOG = ZVM + MLSTM_WIDTH, ZGI = ZOG + MLSTM_WIDTH, ZGF = ZGI + N_HEADS_M;
constexpr size_t O_Y = 0, O_YS = O_Y + (size_t)BATCH * SEQ * D_MODEL, O_KP = O_YS + (size_t)R_SAMPLE * D_MODEL,
    O_VP = O_KP + (size_t)BATCH * T * ATT_WIDTH, O_CP = O_VP + (size_t)BATCH * T * ATT_WIDTH,
    O_NP = O_CP + (size_t)BATCH * N_HEADS_M * HEAD_DIM_M * HEAD_DIM_M, O_MP = O_NP + (size_t)BATCH * N_HEADS_M * HEAD_DIM_M,
    O_CVP = O_MP + (size_t)BATCH * N_HEADS_M, O_KS = O_CVP + (size_t)BATCH * 3 * MLSTM_WIDTH, O_VS = O_KS + (size_t)R_SAMPLE * ATT_WIDTH,
    O_CS = O_VS + (size_t)R_SAMPLE * ATT_WIDTH, O_NS = O_CS + (size_t)DEC_BATCH * N_HEADS_M * HEAD_DIM_M * HEAD_DIM_M,
    O_MS = O_NS + (size_t)DEC_BATCH * N_HEADS_M * HEAD_DIM_M, O_CVS = O_MS + (size_t)DEC_BATCH * N_HEADS_M, O_END = O_CVS + (size_t)DEC_BATCH * 3 * MLSTM_WIDTH;
}
__device__ __forceinline__ int lane_now() { int l; asm volatile("v_mbcnt_lo_u32_b32 %0, -1, 0\n\tv_mbcnt_hi_u32_b32 %0, -1, %0" : "=v"(l)); return l; }
namespace pg8 {
#define PG8_LAS __attribute__((address_space(3)))
typedef unsigned short bf16_t;
typedef short bf16x8 __attribute__((ext_vector_type(8)));
typedef float f32x4 __attribute__((ext_vector_type(4)));
typedef unsigned u32x4 __attribute__((ext_vector_type(4)));
constexpr int BM = 256, BK = 64, HALF = 128, HTB = HALF * BK * 2  , STAGE_BYTES = 8 * HTB, NXCD = 8, WGM = 8;

__host__ __device__ __forceinline__ int lds_byte(int r, int c) { const int st = (r >> 4) * 2 + (c >> 5), rr = r & 15, cc = c & 31, ob = rr * 64 + cc * 2; return st * 1024 + (ob ^ (((ob >> 9) & 1) << 5)); }
__host__ __device__ __forceinline__ void stage_rc(int b, int& R, int& C) { const int st = b / 1024, sb = b % 1024, swz = sb ^ (((sb >> 9) & 1) << 5); R = (st >> 1) * 16 + swz / 64; C = (st & 1) * 32 + (swz % 64) / 2; }
__host__ __device__ __forceinline__ int perm32(int rho) { const int n = rho >> 4, i = rho & 15; return 8 * (i >> 2) + 4 * n + (i & 3); }

struct Unit { int pm, pn; };
struct Gemm { const bf16_t* A; const bf16_t* Bt; int M, N, K, lda, ldb;
    int pbt, skew_rows;
    int grp_pn, grp_a_cols;
    __device__ __forceinline__ size_t a_off(int pm, int pn) const { size_t r = (size_t)pm * BM; if (pbt) r += (size_t)(pm / pbt + 1) * skew_rows; size_t o = r * lda; if (grp_pn) o += (size_t)(pn / grp_pn) * grp_a_cols; return o * 2; } };

struct StaticOrder {
    int nM, nN, nwg, G, c;
    __host__ __device__ void init(int M, int N, int G_, int c_) { nM = M / BM; nN = N / BM; nwg = nM * nN; G = G_; c = c_; }
    __host__ __device__ bool next(int i, Unit& u) const {
        const long L = (long)i * G + c; if (L >= nwg) return false;
        int wgid = (int)L; { const int q = nwg / NXCD, r = nwg % NXCD, xcd = wgid % NXCD, off = wgid / NXCD; wgid = (xcd < r ? xcd * (q + 1) : r * (q + 1) + (xcd - r) * q) + off; }
        const int nig = WGM * nN, gid = wgid / nig, fm = gid * WGM, gsz = (nM - fm) < WGM ? (nM - fm) : WGM;
        u.pm = fm + ((wgid % nig) % gsz); u.pn = (wgid % nig) / gsz; return true;
    }
    __device__ __forceinline__ void a_ready(const Unit&) const {}
    __device__ __forceinline__ void done(const Unit&) const {}
};

struct RangeOrder { StaticOrder b; int lo, hi;
    __device__ __forceinline__ bool next(int i, Unit& u) const { return lo + i < hi && b.next(lo + i, u); }
    __device__ __forceinline__ void a_ready(const Unit&) const {}
    __device__ __forceinline__ void done(const Unit&) const {}
};
struct PairOrder { int pm, pn0;
    __device__ __forceinline__ bool next(int i, Unit& u) const { if (i >= 2) return false; u.pm = pm; u.pn = pn0 + i; return true; }
    __device__ __forceinline__ void a_ready(const Unit&) const {}
    __device__ __forceinline__ void done(const Unit&) const {}
};
__device__ __forceinline__ unsigned cvt_pk_bf16(float lo, float hi) { unsigned r; asm volatile("v_cvt_pk_bf16_f32 %0, %1, %2" : "=v"(r) : "v"(lo), "v"(hi)); return r; }
typedef unsigned u32x2 __attribute__((ext_vector_type(2)));
constexpr float RMS_EPS = 1e-6f;

struct EpiOutProj {
    static constexpr bool PERM = false, AFTER_DRAIN = true, B64 = false;
    const float* resid; float* x1; bf16_t* xn2; const float* gain; float* ssq; int ldc;
    __device__ __forceinline__ void fused(f32x4 (&acc)[2][2][4][2], const Unit& u, int wr, int wc, int fr, int fq, PG8_LAS unsigned char* lds, int wid, int lane) const {
        PG8_LAS float* P = (PG8_LAS float*)lds;
        const int col0 = u.pn * BM + wc * 32 + 4 * fq;
        f32x4 gv[2][2];
#pragma unroll
        for (int bj = 0; bj < 2; ++bj)
#pragma unroll
            for (int n = 0; n < 2; ++n) gv[bj][n] = *(const f32x4*)(gain + col0 + bj * HALF + n * 16);
#pragma unroll
        for (int ai = 0; ai < 2; ++ai) { f32x4 rs[4][2][2];
#pragma unroll
            for (int m = 0; m < 4; ++m) { const size_t off = (size_t)(u.pm * BM + ai * HALF + wr * 64 + m * 16 + fr) * ldc + col0;
#pragma unroll
                for (int bj = 0; bj < 2; ++bj)
#pragma unroll
                    for (int n = 0; n < 2; ++n) rs[m][bj][n] = *(const f32x4*)(resid + off + bj * HALF + n * 16); }
#pragma unroll
            for (int m = 0; m < 4; ++m) { const int r = ai * HALF + wr * 64 + m * 16 + fr; const size_t off = (size_t)(u.pm * BM + r) * ldc + col0; float s = 0.f;
#pragma unroll
                for (int bj = 0; bj < 2; ++bj)
#pragma unroll
                    for (int n = 0; n < 2; ++n) { const f32x4 x = rs[m][bj][n] + acc[ai][bj][m][n];
                        *(f32x4*)(x1 + off + bj * HALF + n * 16) = x; s += (x[0] * x[0] + x[1] * x[1]) + (x[2] * x[2] + x[3] * x[3]);
                        const f32x4 y = x * gv[bj][n]; u32x2 w; w.x = cvt_pk_bf16(y[0], y[1]); w.y = cvt_pk_bf16(y[2], y[3]); *(u32x2*)(xn2 + off + bj * HALF + n * 16) = w; }
                s += __shfl_xor(s, 16); s += __shfl_xor(s, 32);
                if (fq == 0) P[r * 4 + wc] = s; }
            asm volatile("" ::: "memory"); }
        asm volatile("s_waitcnt lgkmcnt(0)" ::: "memory"); __builtin_amdgcn_s_barrier(); asm volatile("" ::: "memory");
        const int tid = wid * 64 + lane;
        if (tid < BM) ssq[(size_t)(u.pm * BM + tid) * 8 + u.pn] = (P[tid * 4 + 0] + P[tid * 4 + 1]) + (P[tid * 4 + 2] + P[tid * 4 + 3]);
    }
};
struct EpiUp {
    static constexpr bool PERM = true, AFTER_DRAIN = false, B64 = false;
    bf16_t* O; int ldc; const float* ssq; float inv_n;
    __device__ __forceinline__ void operator()(const f32x4 (&acc)[2][2][4][2], const Unit& u, int wr, int wc, int fr, int fq) const {
        const int row0 = u.pm * BM + wr * 64 + fr, col0 = u.pn * BM + wc * 32 + 8 * fq;
#pragma unroll
        for (int ai = 0; ai < 2; ++ai)
#pragma unroll
            for (int m = 0; m < 4; ++m) { const int row = row0 + ai * HALF + m * 16; const f32x4 a = *(const f32x4*)(ssq + (size_t)row * 8), b = *(const f32x4*)(ssq + (size_t)row * 8 + 4);
                const float rs = 1.0f / sqrtf(((a[0] + a[1]) + (a[2] + a[3]) + (b[0] + b[1]) + (b[2] + b[3])) * inv_n + RMS_EPS);
                bf16_t* rowp = O + (size_t)row * ldc + col0;
#pragma unroll
                for (int bj = 0; bj < 2; ++bj) { f32x4 v0 = acc[ai][bj][m][0] * rs, v1 = acc[ai][bj][m][1] * rs;
#pragma unroll
                    for (int j = 0; j < 4; ++j) { v0[j] = v0[j] > 0.f ? v0[j] * v0[j] : 0.f; v1[j] = v1[j] > 0.f ? v1[j] * v1[j] : 0.f; }
                    u32x4 w; w.x = cvt_pk_bf16(v0[0], v0[1]); w.y = cvt_pk_bf16(v0[2], v0[3]); w.z = cvt_pk_bf16(v1[0], v1[1]); w.w = cvt_pk_bf16(v1[2], v1[3]);
                    *(u32x4*)(rowp + bj * HALF) = w; } }
    }
};
struct EpiDown {
    static constexpr bool PERM = false, AFTER_DRAIN = false, B64 = false;
    const float* x1; float* out; int ldc;
    __device__ __forceinline__ void operator()(const f32x4 (&acc)[2][2][4][2], const Unit& u, int wr, int wc, int fr, int fq) const {
        const int col0 = u.pn * BM + wc * 32 + 4 * fq;
#pragma unroll
        for (int ai = 0; ai < 2; ++ai) { f32x4 rs[4][2][2];
#pragma unroll
            for (int m = 0; m < 4; ++m) { const size_t off = (size_t)(u.pm * BM + ai * HALF + wr * 64 + m * 16 + fr) * ldc + col0;
#pragma unroll
                for (int bj = 0; bj < 2; ++bj)
#pragma unroll
                    for (int n = 0; n < 2; ++n) rs[m][bj][n] = *(const f32x4*)(x1 + off + bj * HALF + n * 16); }
#pragma unroll
            for (int m = 0; m < 4; ++m) { const size_t off = (size_t)(u.pm * BM + ai * HALF + wr * 64 + m * 16 + fr) * ldc + col0;
#pragma unroll
                for (int bj = 0; bj < 2; ++bj)
#pragma unroll
                    for (int n = 0; n < 2; ++n) *(f32x4*)(out + off + bj * HALF + n * 16) = rs[m][bj][n] + acc[ai][bj][m][n]; }
            asm volatile("" ::: "memory"); }
    }
};
struct EpiInProj {
    static constexpr bool PERM = true, AFTER_DRAIN = false, B64 = true;
    bf16_t *Qs, *Ks, *Vs, *Us, *VMs, *OGs; float *okp, *ovp, *ocvp; const float *q_g, *k_g; float qscale; int T_, SEQ_, NMETA_;
    __device__ __forceinline__ void operator()(const f32x4 (&acc)[2][2][4][2], const Unit& u, int wr, int wc, int fr, int fq) const {
        const int typ = u.pn >> 2, b = (u.pm * BM) / SEQ_, s0 = (u.pm * BM) % SEQ_ + wr * 64 + fr;
        const unsigned cb = (unsigned)((u.pn & 3) * 256 + wc * 64 + 8 * fq);
        const unsigned off0 = ((unsigned)(b * T_ + NMETA_ + s0)) * 1024u + cb;
        bf16_t* dst = typ == 0 ? Qs : typ == 1 ? Ks : typ == 2 ? Vs : typ == 3 ? Us : typ == 4 ? VMs : OGs;
        float* fo = typ == 1 ? okp : typ == 2 ? ovp : nullptr;
        const bool nrm = typ <= 1; const float sc = typ == 0 ? qscale : 1.0f;
        f32x4 gv[2][2];
#pragma unroll
        for (int bj = 0; bj < 2; ++bj)
#pragma unroll
            for (int n = 0; n < 2; ++n) gv[bj][n] = nrm ? *(const f32x4*)((typ ? k_g : q_g) + 8 * fq + 32 * bj + 4 * n) : (f32x4){1.f, 1.f, 1.f, 1.f};
#pragma unroll
        for (int ai = 0; ai < 2; ++ai)
#pragma unroll
            for (int m = 0; m < 4; ++m) { float rr = sc;
                if (nrm) { float ss = 0.f;
#pragma unroll
                    for (int bj = 0; bj < 2; ++bj)
#pragma unroll
                        for (int n = 0; n < 2; ++n) { const f32x4 x = acc[ai][bj][m][n]; ss += (x[0] * x[0] + x[1] * x[1]) + (x[2] * x[2] + x[3] * x[3]); }
                    ss += __shfl_xor(ss, 16); ss += __shfl_xor(ss, 32);
                    rr = sc / sqrtf(ss * (1.0f / 64.0f) + RMS_EPS); }
                const unsigned off = off0 + (unsigned)(ai * HALF + m * 16) * 1024u; const int s = s0 + ai * HALF + m * 16;
#pragma unroll
                for (int bj = 0; bj < 2; ++bj) { const f32x4 v0 = acc[ai][bj][m][0] * rr * gv[bj][0], v1 = acc[ai][bj][m][1] * rr * gv[bj][1];
                    if (fo) { float* o = fo + off + 32 * bj; *(f32x4*)o = v0; *(f32x4*)(o + 4) = v1; }
                    if (typ == 3 && s >= SEQ_ - 3) { float* o = ocvp + (unsigned)((b * 3 + (s - (SEQ_ - 3))) * 1024) + cb + 32 * bj; *(f32x4*)o = v0; *(f32x4*)(o + 4) = v1; }
                    u32x4 w; w.x = cvt_pk_bf16(v0[0], v0[1]); w.y = cvt_pk_bf16(v0[2], v0[3]); w.z = cvt_pk_bf16(v1[0], v1[1]); w.w = cvt_pk_bf16(v1[2], v1[3]);
                    *(u32x4*)(dst + off + 32 * bj) = w; }
                asm volatile("" ::: "memory"); }
    }
};
struct EpiQK {
    static constexpr bool PERM = true, AFTER_DRAIN = false, B64 = false;
    bf16_t* MQs; long long kdelta; int T_, SEQ_, NMETA_, pad_;
    __device__ __forceinline__ void operator()(const f32x4 (&acc)[2][2][4][2], const Unit& u, int wr, int wc, int fr, int fq) const {
        const int head = u.pn >> 1, b = (u.pm * BM) / SEQ_, s0 = (u.pm * BM) % SEQ_ + wr * 64 + fr; bf16_t* dst = MQs + (long long)(u.pn & 1) * kdelta;
        const unsigned off0 = ((unsigned)(b * T_ + NMETA_ + s0)) * 1024u + (unsigned)(head * 256 + wc * 32 + 8 * fq);
#pragma unroll
        for (int ai = 0; ai < 2; ++ai)
#pragma unroll
            for (int m = 0; m < 4; ++m) { const unsigned off = off0 + (unsigned)(ai * HALF + m * 16) * 1024u;
#pragma unroll
                for (int bj = 0; bj < 2; ++bj) { const f32x4 v0 = acc[ai][bj][m][0], v1 = acc[ai][bj][m][1];
                    u32x4 w; w.x = cvt_pk_bf16(v0[0], v0[1]); w.y = cvt_pk_bf16(v0[2], v0[3]); w.z = cvt_pk_bf16(v1[0], v1[1]); w.w = cvt_pk_bf16(v1[2], v1[3]);
                    *(u32x4*)(dst + off + bj * HALF) = w; }
                asm volatile("" ::: "memory"); }
    }
};
struct EpiQKwt {
    static constexpr bool PERM = true, AFTER_DRAIN = false, B64 = false;
    bf16_t* MQs; long long kdelta; int T_, SEQ_, NMETA_, rs_bytes;
    __device__ __forceinline__ void operator()(const f32x4 (&acc)[2][2][4][2], const Unit& u, int wr, int wc, int fr, int fq) const {
        const int head = u.pn >> 1, b = (u.pm * BM) / SEQ_, s0 = (u.pm * BM) % SEQ_ + wr * 64 + fr; const __amdgpu_buffer_rsrc_t rs = __builtin_amdgcn_make_buffer_rsrc((void*)(MQs + (long long)(u.pn & 1) * kdelta), 0, rs_bytes, 0x00020000);
        const unsigned off0 = ((unsigned)(b * T_ + NMETA_ + s0)) * 1024u + (unsigned)(head * 256 + wc * 32 + 8 * fq);
#pragma unroll
        for (int ai = 0; ai < 2; ++ai)
#pragma unroll
            for (int m = 0; m < 4; ++m) { const unsigned off = off0 + (unsigned)(ai * HALF + m * 16) * 1024u;
#pragma unroll
                for (int bj = 0; bj < 2; ++bj) { const f32x4 v0 = acc[ai][bj][m][0], v1 = acc[ai][bj][m][1];
                    u32x4 w; w.x = cvt_pk_bf16(v0[0], v0[1]); w.y = cvt_pk_bf16(v0[2], v0[3]); w.z = cvt_pk_bf16(v1[0], v1[1]); w.w = cvt_pk_bf16(v1[2], v1[3]);
                    __builtin_amdgcn_raw_buffer_store_b128(w, rs, (int)((off + bj * HALF) * 2u), 0, 16); }
                asm volatile("" ::: "memory"); }
    }
};
template <class Epi, class Sched, bool ALIGN_EPI = false, bool SP2 = false>
__device__ __forceinline__ void gemm_phase(PG8_LAS unsigned char* lds, const Gemm g, const Sched& S, const Epi& E, const int wave_) {
    const int tid_ = wave_ * 64 + lane_now();
    const int tid = tid_, wid = wave_, lane = tid & 63, wr = wid >> 2, wc = wid & 3, fr = lane & 15, fq = lane >> 4;
    const int K = g.K, nt = K / BK;
    unsigned voffA[2], voffB[2];
#pragma unroll
    for (int i = 0; i < 2; ++i) { int R, C; stage_rc(tid * 16 + i * 8192, R, C); const int Rb = Epi::PERM ? ((R & ~31) + perm32(R & 31)) : R;
        const int Rb2 = Epi::B64 ? ((Rb >> 5) * 64 + (Rb & 31)) : Rb;
        voffA[i] = (unsigned)(R * g.lda + C) * 2u; voffB[i] = (unsigned)(Rb2 * g.ldb + C) * 2u; }
    const size_t kstep = (size_t)(BK * 2);
    const size_t hstepA = (size_t)HALF * g.lda * 2;
    const size_t hstepB = (size_t)(Epi::B64 ? 32 : HALF) * g.ldb * 2;
    const size_t tstepB = (size_t)BM * g.ldb * 2;
    const unsigned ldsw = (unsigned)wid * 1024u;
    const int aoff = lds_byte(wr * 64 + fr, fq * 8), boff = lds_byte(wc * 32 + fr, fq * 8);
#define PG8_SA(b, h) (((b) * 2 + (h)) * HTB)
#define PG8_SB(b, h) ((4 + (b) * 2 + (h)) * HTB)
#define PG8_STAGE(bufoff, gbase, voff) do { _Pragma("unroll") for (int _i = 0; _i < 2; ++_i) \
        __builtin_amdgcn_global_load_lds((const unsigned*)((const char*)(gbase) + (voff)[_i]), (PG8_LAS unsigned*)(lds + (bufoff) + ldsw + _i * 8192), 16, 0, 0); } while (0)
#define PG8_LDA(dst, b, h) do { _Pragma("unroll") for (int m = 0; m < 4; ++m) _Pragma("unroll") for (int k = 0; k < 2; ++k) dst[m][k] = *(const PG8_LAS bf16x8*)(lds + PG8_SA(b, h) + aoff + m * 2048 + k * 1024); } while (0)
#define PG8_LDB(dst, b, h) do { _Pragma("unroll") for (int n = 0; n < 2; ++n) _Pragma("unroll") for (int k = 0; k < 2; ++k) dst[n][k] = *(const PG8_LAS bf16x8*)(lds + PG8_SB(b, h) + boff + n * 2048 + k * 1024); } while (0)
#define PG8_MMA(ai, bj, At, Bt) do { __builtin_amdgcn_s_setprio(1); _Pragma("unroll") for (int m = 0; m < 4; ++m) _Pragma("unroll") for (int n = 0; n < 2; ++n) _Pragma("unroll") for (int k = 0; k < 2; ++k) \
        acc[ai][bj][m][n] = __builtin_amdgcn_mfma_f32_16x16x32_bf16(Bt[n][k], At[m][k], acc[ai][bj][m][n], 0, 0, 0); __builtin_amdgcn_s_setprio(0); } while (0)
#define PG8_WAIT_V(n) asm volatile("s_waitcnt vmcnt(" #n ")" ::: "memory")
#define PG8_WAIT_L(n) asm volatile("s_waitcnt lgkmcnt(" #n ")" ::: "memory")
#define PG8_BAR __builtin_amdgcn_s_barrier()
#define PG8_SCHED __builtin_amdgcn_sched_barrier(0)
    Unit cur, nxt; int ui = 0;
    if (!S.next(0, cur)) return;
    f32x4 acc[2][2][4][2];
#pragma unroll
    for (int a = 0; a < 2; ++a)
#pragma unroll
        for (int b = 0; b < 2; ++b)
#pragma unroll
            for (int m = 0; m < 4; ++m)
#pragma unroll
                for (int n = 0; n < 2; ++n) acc[a][b][m][n] = (f32x4){0.f, 0.f, 0.f, 0.f};
    bf16x8 At[4][2], B0[2][2], B1[2][2];
    const char* cA = (const char*)g.A + g.a_off(cur.pm, cur.pn); const char* cB = (const char*)g.Bt + (size_t)cur.pn * tstepB;
    S.a_ready(cur);
    if constexpr (SP2) {
        PG8_STAGE(PG8_SB(0, 0), cB, voffB); PG8_STAGE(PG8_SB(0, 1), cB + hstepB, voffB); PG8_STAGE(PG8_SA(0, 0), cA, voffA); PG8_STAGE(PG8_SA(0, 1), cA + hstepA, voffA);
        if (wr == 1) PG8_BAR;
        PG8_WAIT_V(2); PG8_BAR;
        PG8_STAGE(PG8_SB(1, 0), cB + kstep, voffB); PG8_STAGE(PG8_SA(1, 0), cA + kstep, voffA); PG8_STAGE(PG8_SB(1, 1), cB + hstepB + kstep, voffB);
        PG8_WAIT_V(6); PG8_BAR;
    } else {
        PG8_STAGE(PG8_SB(0, 0), cB, voffB); PG8_STAGE(PG8_SA(0, 0), cA, voffA); PG8_STAGE(PG8_SB(0, 1), cB + hstepB, voffB); PG8_STAGE(PG8_SA(0, 1), cA + hstepA, voffA);
        if (wr == 1) PG8_BAR;
        PG8_WAIT_V(4); PG8_BAR;
        PG8_STAGE(PG8_SB(1, 0), cB + kstep, voffB); PG8_STAGE(PG8_SA(1, 0), cA + kstep, voffA); PG8_STAGE(PG8_SB(1, 1), cB + hstepB + kstep, voffB);
        PG8_WAIT_V(6); PG8_BAR;
    }
    for (;;) {
        const bool has_next = S.next(ui + 1, nxt);
        const char* nA = has_next ? (const char*)g.A + g.a_off(nxt.pm, nxt.pn) : cA; const char* nB = has_next ? (const char*)g.Bt + (size_t)nxt.pn * tstepB : cB;
#pragma nounroll
        for (int t = 0; t < nt; t += 2) {
            const bool last = (t == nt - 2);
            const char* a1 = cA + (size_t)(t + 1) * kstep;
            const char* a2 = last ? nA : cA + (size_t)(t + 2) * kstep; const char* b2 = last ? nB : cB + (size_t)(t + 2) * kstep;
            const char* a3 = a2 + kstep; const char* b3 = b2 + kstep;
            if (last && has_next) S.a_ready(nxt);
            if constexpr (SP2) {
            PG8_LDB(B0, 0, 0); PG8_LDB(B1, 0, 1); PG8_SCHED; PG8_LDA(At, 0, 0); PG8_STAGE(PG8_SA(1, 1), a1 + hstepA, voffA);
            PG8_WAIT_V(8); PG8_WAIT_L(0); PG8_BAR; PG8_MMA(0, 0, At, B0); PG8_MMA(0, 1, At, B1); PG8_BAR; PG8_SCHED;
            PG8_LDA(At, 0, 1); PG8_STAGE(PG8_SB(0, 0), b2, voffB); PG8_STAGE(PG8_SB(0, 1), b2 + hstepB, voffB); PG8_STAGE(PG8_SA(0, 0), a2, voffA);
            PG8_WAIT_V(8); PG8_WAIT_L(0); PG8_BAR; PG8_MMA(1, 0, At, B0); PG8_MMA(1, 1, At, B1); PG8_BAR; PG8_SCHED;
            PG8_LDB(B0, 1, 0); PG8_LDB(B1, 1, 1); PG8_SCHED; PG8_LDA(At, 1, 0); PG8_STAGE(PG8_SA(0, 1), a2 + hstepA, voffA);
            PG8_WAIT_V(8); PG8_WAIT_L(0); PG8_BAR; PG8_MMA(0, 0, At, B0); PG8_MMA(0, 1, At, B1); PG8_BAR; PG8_SCHED;
            PG8_LDA(At, 1, 1); PG8_STAGE(PG8_SB(1, 0), b3, voffB); PG8_STAGE(PG8_SB(1, 1), b3 + hstepB, voffB); PG8_STAGE(PG8_SA(1, 0), a3, voffA);
            PG8_WAIT_V(8); PG8_WAIT_L(0); PG8_BAR; PG8_MMA(1, 0, At, B0); PG8_MMA(1, 1, At, B1); PG8_BAR; PG8_SCHED;
            } else {
            PG8_LDB(B0, 0, 0); PG8_SCHED; PG8_LDA(At, 0, 0); PG8_STAGE(PG8_SA(1, 1), a1 + hstepA, voffA);
            PG8_WAIT_L(8); PG8_BAR; PG8_WAIT_L(0); PG8_MMA(0, 0, At, B0); PG8_BAR; PG8_SCHED;
            PG8_LDB(B1, 0, 1); PG8_STAGE(PG8_SB(0, 0), b2, voffB);
            PG8_BAR; PG8_WAIT_L(0); PG8_MMA(0, 1, At, B1); PG8_BAR;
            PG8_LDA(At, 0, 1); PG8_STAGE(PG8_SA(0, 0), a2, voffA);
            PG8_BAR; PG8_WAIT_L(0); PG8_MMA(1, 0, At, B0); PG8_BAR; PG8_SCHED;
            PG8_STAGE(PG8_SB(0, 1), b2 + hstepB, voffB);
            PG8_WAIT_V(6); PG8_BAR; PG8_MMA(1, 1, At, B1); PG8_BAR;
            PG8_LDB(B0, 1, 0); PG8_SCHED; PG8_LDA(At, 1, 0); PG8_STAGE(PG8_SA(0, 1), a2 + hstepA, voffA);
            PG8_WAIT_L(8); PG8_BAR; PG8_WAIT_L(0); PG8_MMA(0, 0, At, B0); PG8_BAR; PG8_SCHED;
            PG8_LDB(B1, 1, 1); PG8_STAGE(PG8_SB(1, 0), b3, voffB);
            PG8_BAR; PG8_WAIT_L(0); PG8_MMA(0, 1, At, B1); PG8_BAR;
            PG8_LDA(At, 1, 1); PG8_STAGE(PG8_SA(1, 0), a3, voffA);
            PG8_BAR; PG8_WAIT_L(0); PG8_MMA(1, 0, At, B0); PG8_BAR; PG8_SCHED;
            PG8_STAGE(PG8_SB(1, 1), b3 + hstepB, voffB);
            PG8_WAIT_V(6); PG8_BAR; PG8_MMA(1, 1, At, B1); PG8_BAR;
            }
        }
        if constexpr (ALIGN_EPI) { if (wr == 0) PG8_BAR; }
        if constexpr (!Epi::AFTER_DRAIN) { E(acc, cur, wr, wc, fr, fq); S.done(cur); }
        if (!has_next) break;
#pragma unroll
        for (int a = 0; a < 2; ++a)
#pragma unroll
            for (int b = 0; b < 2; ++b)
#pragma unroll
                for (int m = 0; m < 4; ++m)
#pragma unroll
                    for (int n = 0; n < 2; ++n) acc[a][b][m][n] = (f32x4){0.f, 0.f, 0.f, 0.f};
        cur = nxt; cA = nA; cB = nB; ++ui;
        if constexpr (ALIGN_EPI) { if (wr == 1) PG8_BAR; }
    }
    PG8_WAIT_V(0);
    if constexpr (!ALIGN_EPI) { if (wr == 0) PG8_BAR; }
    PG8_BAR;
    if constexpr (Epi::AFTER_DRAIN) { E.fused(acc, cur, wr, wc, fr, fq, lds, wid, lane); S.done(cur); }
#undef PG8_SA
#undef PG8_SB
#undef PG8_STAGE
#undef PG8_LDA
#undef PG8_LDB
#undef PG8_MMA
#undef PG8_WAIT_V
#undef PG8_WAIT_L
#undef PG8_BAR
#undef PG8_SCHED
}
}
#define GAS __attribute__((address_space(1)))
#define LAS __attribute__((address_space(3)))
typedef unsigned short bf16;
typedef unsigned v4u __attribute__((ext_vector_type(4)));
typedef float f32x4 __attribute__((ext_vector_type(4)));
typedef short bf16x8 __attribute__((ext_vector_type(8)));
typedef GAS unsigned gu32;
typedef GAS unsigned long long gu64;
#define RLX_AGENT __ATOMIC_RELAXED, __HIP_MEMORY_SCOPE_AGENT
#define LDS_WAIT() asm volatile("s_waitcnt lgkmcnt(0)" ::: "memory")
#define VM_WAIT() asm volatile("s_waitcnt vmcnt(0)" ::: "memory")
__device__ __forceinline__ unsigned long long rt() { return __builtin_amdgcn_s_memrealtime(); }
__device__ __forceinline__ unsigned f2bf(float f) { unsigned u = __builtin_bit_cast(unsigned, f); return (u + 0x7fffu + ((u >> 16) & 1u)) >> 16; }
__device__ __forceinline__ unsigned pk2(float lo, float hi) { return f2bf(lo) | (f2bf(hi) << 16); }

#define XB_TMO      128
#define XB_XCNT(j)  (256  + 64 * (j))
#define XB_XSUB(j)  (1280 + 64 * (j))
#define XB_XGEN(j)  (2304 + 64 * (j))
#define XB_TOP      3328
#define XB_TOPGEN   3392
#define XCD_BAR_WORDS 3456
#define XB_SPIN_CAP (1u << 18)

__device__ __forceinline__ unsigned xb_ld(unsigned* p)              { return __hip_atomic_load(p, __ATOMIC_RELAXED, __HIP_MEMORY_SCOPE_AGENT); }
__device__ __forceinline__ unsigned xb_add(unsigned* p, unsigned v) { return __hip_atomic_fetch_add(p, v, __ATOMIC_RELAXED, __HIP_MEMORY_SCOPE_AGENT); }
__device__ __forceinline__ unsigned xb_xcc_id() { return (unsigned)__builtin_amdgcn_s_getreg((3 << 11) | 20) & 0xFu; }
#define XB_SPIN(cond, bar) do { unsigned _sp = 0; while (cond) { __builtin_amdgcn_s_sleep(1); \
    if ((++_sp & 255u) == 0u) { if (xb_ld(&(bar)[XB_TMO])) break; if (_sp > XB_SPIN_CAP) { atomicAdd(&(bar)[XB_TMO], 1u); break; } } } } while (0)

struct XcdBarrier {
    unsigned* bar; unsigned x;
    volatile LAS unsigned* st;
};

__device__ __forceinline__ XcdBarrier xcd_barrier_post(unsigned* bar, volatile LAS unsigned* st) {
    XcdBarrier b; b.bar = bar; b.x = xb_xcc_id(); b.st = st;
    if (threadIdx.x == 0) (void)xb_add(&bar[XB_XCNT(b.x)], 1u);
    return b;
}
__device__ __forceinline__ void xcd_barrier_complete(unsigned* bar, unsigned x, unsigned& nloc, unsigned& nx) {
    const unsigned G = gridDim.x * gridDim.y * gridDim.z;
    unsigned sum, cnt, mine, sp = 0u;
    for (;;) {
        sum = 0u; cnt = 0u; mine = 0u;
#pragma unroll
        for (unsigned j = 0; j < 16; ++j) { const unsigned c = xb_ld(&bar[XB_XCNT(j)]); sum += c; cnt += (c > 0u) ? 1u : 0u; mine = (j == x) ? c : mine; }
        if (sum == G) break;
        __builtin_amdgcn_s_sleep(1);
        if ((++sp & 255u) == 0u) { if (xb_ld(&bar[XB_TMO])) break; if (sp > XB_SPIN_CAP) { atomicAdd(&bar[XB_TMO], 1u); break; } }
    }
    nloc = mine > 0u ? mine : 1u; nx = cnt > 0u ? cnt : 1u;
}

__device__ __forceinline__ void xcd_barrier(const XcdBarrier& b, const int wave_) {
    asm volatile("s_waitcnt vmcnt(0)" ::: "memory");
    __syncthreads();
    if (wave_ == 0 && lane_now() == 0) {
        unsigned* bar = b.bar;
        __builtin_amdgcn_s_waitcnt(0);
        unsigned nloc = b.st[0], nx = b.st[1];
        if (nloc == 0u) { xcd_barrier_complete(bar, b.x, nloc, nx); b.st[0] = nloc; b.st[1] = nx; }
        const unsigned old = xb_add(&bar[XB_XSUB(b.x)], 1u);
        const unsigned gen = old / nloc;
        if (old + 1u == (gen + 1u) * nloc) {
            __builtin_amdgcn_fence(__ATOMIC_RELEASE, "agent");
            asm volatile("s_waitcnt vmcnt(0)" ::: "memory");
            const unsigned og = xb_add(&bar[XB_TOP], 1u);
            const unsigned tg = og / nx;
            if (og + 1u == (tg + 1u) * nx) xb_add(&bar[XB_TOPGEN], 1u);
            else XB_SPIN(xb_ld(&bar[XB_TOPGEN]) == tg, bar);
            __builtin_amdgcn_fence(__ATOMIC_ACQUIRE, "agent");
            xb_add(&bar[XB_XGEN(b.x)], 1u);
            asm volatile("s_waitcnt vmcnt(0)" ::: "memory");
        } else {
            XB_SPIN(xb_ld(&bar[XB_XGEN(b.x)]) == gen, bar);
            __builtin_amdgcn_fence(__ATOMIC_ACQUIRE, "agent");
            asm volatile("s_waitcnt vmcnt(0)" ::: "memory");
        }
    }
    __syncthreads();
}
namespace att {
using namespace cfg;
typedef float f32x16 __attribute__((ext_vector_type(16)));
typedef short s16x4 __attribute__((ext_vector_type(4)));
typedef short v4i16_t __attribute__((ext_vector_type(4)));
typedef unsigned u32x4 __attribute__((ext_vector_type(4)));
constexpr int ST_K = 0, ST_V = 16384, ST_BYTES = 32768;
__device__ __forceinline__ int crow(int i, int hh) { return (i & 3) + 8 * (i >> 2) + 4 * hh; }
__device__ __forceinline__ float swapmax(float x) { auto rr = __builtin_amdgcn_permlane32_swap(__float_as_uint(x), __float_as_uint(x), false, false); return fmaxf(__uint_as_float(rr[0]), __uint_as_float(rr[1])); }
__device__ __forceinline__ float swapadd(float x) { auto rr = __builtin_amdgcn_permlane32_swap(__float_as_uint(x), __float_as_uint(x), false, false); return __uint_as_float(rr[0]) + __uint_as_float(rr[1]); }
__device__ __forceinline__ s16x4 vtr(const LAS unsigned char* p) { return __builtin_bit_cast(s16x4, __builtin_amdgcn_ds_read_tr16_b64_v4i16((LAS v4i16_t*)p)); }
__device__ __forceinline__ unsigned pkbf(float lo, float hi) { unsigned r; asm volatile("v_cvt_pk_bf16_f32 %0, %1, %2" : "=v"(r) : "v"(lo), "v"(hi)); return r; }
__device__ __forceinline__ void glds16(const void* gsrc, const LAS unsigned char* dst) { unsigned keep; const unsigned d = (unsigned)__builtin_amdgcn_readfirstlane((int)(unsigned)(uintptr_t)dst);
    asm volatile("s_mov_b32 %0, m0\n\ts_mov_b32 m0, %2\n\ts_nop 0\n\tglobal_load_lds_dwordx4 %1, off\n\ts_mov_b32 m0, %0" : "=&s"(keep) : "v"(gsrc), "s"(d) : "memory"); }
#define ATT_MFMA(a, b, c) __builtin_amdgcn_mfma_f32_32x32x16_bf16((a), (b), (c), 0, 0, 0)

struct AttnArgs { const bf16 *Qs, *Ks, *Vs; bf16* AO; const float* gain; float lam, one_minus_lam_init; };

__device__ __forceinline__ void stage_tile(const AttnArgs& A, LAS unsigned char* st, int rowbase, int t, int h, int wave, int lane) {
#pragma unroll
    for (int i = 0; i < 2; ++i) { const int c = 2 * wave + i; int key = 64 * t + lane; key = key < T ? key : T - 1;
        glds16(A.Ks + (size_t)(rowbase + key) * 1024 + h * 128 + c * 8, st + ST_K + c * 1024); }
#pragma unroll
    for (int i = 0; i < 2; ++i) { const int p = 2 * wave + i, eb = p >> 2, rg = p & 3; int key = 64 * t + 16 * rg + (lane >> 2); key = key < T ? key : T - 1;
        glds16(A.Vs + (size_t)(rowbase + key) * 1024 + h * 128 + eb * 32 + (lane & 3) * 8, st + ST_V + p * 1024); }
}

__device__ __forceinline__ void attn_unit(const AttnArgs& A, LAS unsigned char* lds, int b, int h, int jb, int tid, int wave, int lane) {
    const int m = wave & 1, qs = wave >> 1, r = lane & 31, hh = lane >> 5;
    const int rowbase = b * T, qp0 = N_META + 128 * jb + 32 * qs, qpos = qp0 + r, NT = 2 * jb + 3;
    const float sl2 = exp2f(-8.0f * (float)(h + 1) / (float)N_HEADS_A) * 1.4426950408889634f;
    bf16x8 qf[4];
    { const bf16* qp = A.Qs + (size_t)(rowbase + qpos) * 1024 + h * 128 + m * 64 + 8 * hh;
#pragma unroll
      for (int ds = 0; ds < 4; ++ds) qf[ds] = *(const GAS bf16x8*)(qp + 16 * ds); }
    asm volatile("s_waitcnt vmcnt(0)" : "+v"(qf[0]), "+v"(qf[1]), "+v"(qf[2]), "+v"(qf[3]) :: "memory");
    f32x16 o[4];
#pragma unroll
    for (int e = 0; e < 4; ++e)
#pragma unroll
        for (int i = 0; i < 16; ++i) o[e][i] = 0.f;
    float m_run = 0.f, l_run = 0.f; constexpr float ATT_THR = 8.0f;
    const LAS unsigned char* vlane = lds + ST_V + ((lane >> 4) & 1) * 32 + (lane & 3) * 8 + (4 * hh + ((lane & 15) >> 2)) * 64;
    stage_tile(A, lds, rowbase, 0, h, wave, lane);
    if (NT > 1) stage_tile(A, lds + ST_BYTES, rowbase, 1, h, wave, lane);
    int sto = 0, stn = 2 * ST_BYTES;
    for (int t = 0; t < NT; ++t) {
        if (t + 1 < NT) asm volatile("s_waitcnt vmcnt(4)" ::: "memory"); else asm volatile("s_waitcnt vmcnt(0)" ::: "memory");
        asm volatile("s_waitcnt lgkmcnt(0)" ::: "memory"); __builtin_amdgcn_s_barrier(); asm volatile("" ::: "memory");
        if (t + 2 < NT) stage_tile(A, lds + stn, rowbase, t + 2, h, wave, lane);
        if (64 * t <= qp0 + 31) {
            const LAS unsigned char* Kst = lds + sto + ST_K + (m * 8 + hh) * 1024 + r * 16;
            f32x16 p0, p1; const float tb = sl2 * (float)(64 * t - qpos + 4 * hh) - m_run, tb1 = tb + 32.0f * sl2;
#pragma unroll
            for (int i = 0; i < 16; ++i) { p0[i] = fmaf(sl2, (float)((i & 3) + 8 * (i >> 2)), tb); p1[i] = fmaf(sl2, (float)((i & 3) + 8 * (i >> 2)), tb1); }
#pragma unroll
            for (int ds = 0; ds < 4; ++ds) { const bf16x8 k0 = *(const LAS bf16x8*)(Kst + ds * 2048), k1 = *(const LAS bf16x8*)(Kst + ds * 2048 + 512);
                p0 = ATT_MFMA(k0, qf[ds], p0); p1 = ATT_MFMA(k1, qf[ds], p1); }
            __builtin_amdgcn_sched_barrier(0);
            if (64 * t + 63 > qp0) {
#pragma unroll
                for (int i = 0; i < 16; ++i) { const int kp = 64 * t + crow(i, hh); if (kp > qpos) p0[i] = -INFINITY; if (kp + 32 > qpos) p1[i] = -INFINITY; }
            }
            float mx = fmaxf(p0[0], p1[0]);
#pragma unroll
            for (int i = 1; i < 16; ++i) mx = fmaxf(mx, fmaxf(p0[i], p1[i]));
            mx = swapmax(mx);
            if (__any(mx > ATT_THR)) {
                const float dl = fmaxf(mx, 0.f), alpha = __builtin_amdgcn_exp2f(-dl); m_run += dl; l_run *= alpha;
#pragma unroll
                for (int i = 0; i < 16; ++i) { p0[i] -= dl; p1[i] -= dl; }
#pragma unroll
                for (int e = 0; e < 4; ++e)
#pragma unroll
                    for (int i = 0; i < 16; ++i) o[e][i] *= alpha; }
            float rs = 0.f;
#pragma unroll
            for (int i = 0; i < 16; ++i) { p0[i] = __builtin_amdgcn_exp2f(p0[i]); p1[i] = __builtin_amdgcn_exp2f(p1[i]); rs += p0[i] + p1[i]; }
            l_run += rs;
            u32x4 pf[4];
#pragma unroll
            for (int s = 0; s < 2; ++s) { pf[s] = (u32x4){pkbf(p0[8 * s], p0[8 * s + 1]), pkbf(p0[8 * s + 2], p0[8 * s + 3]), pkbf(p0[8 * s + 4], p0[8 * s + 5]), pkbf(p0[8 * s + 6], p0[8 * s + 7])};
                pf[2 + s] = (u32x4){pkbf(p1[8 * s], p1[8 * s + 1]), pkbf(p1[8 * s + 2], p1[8 * s + 3]), pkbf(p1[8 * s + 4], p1[8 * s + 5]), pkbf(p1[8 * s + 6], p1[8 * s + 7])}; }
            const LAS unsigned char* vb = vlane + sto;
            s16x4 vl[2][4], vh[2][4];
#pragma unroll
            for (int e = 0; e < 4; ++e) { vl[0][e] = vtr(vb + e * 4096); vh[0][e] = vtr(vb + e * 4096 + 512); }
#pragma unroll
            for (int s = 0; s < 4; ++s) {
                if (s < 3) {
#pragma unroll
                    for (int e = 0; e < 4; ++e) { vl[(s + 1) & 1][e] = vtr(vb + e * 4096 + (s + 1) * 1024); vh[(s + 1) & 1][e] = vtr(vb + e * 4096 + (s + 1) * 1024 + 512); } }
#pragma unroll
                for (int e = 0; e < 4; ++e) { const s16x4 lo = vl[s & 1][e], hi = vh[s & 1][e];
                    const bf16x8 vf = (bf16x8){lo[0], lo[1], lo[2], lo[3], hi[0], hi[1], hi[2], hi[3]};
                    o[e] = ATT_MFMA(vf, __builtin_bit_cast(bf16x8, pf[s]), o[e]); }
                __builtin_amdgcn_sched_barrier(0); }
        }
        sto = sto == 2 * ST_BYTES ? 0 : sto + ST_BYTES; stn = stn == 2 * ST_BYTES ? 0 : stn + ST_BYTES;
    }
    asm volatile("s_waitcnt lgkmcnt(0)" ::: "memory"); __builtin_amdgcn_s_barrier(); asm volatile("" ::: "memory");
    const float linv = 1.0f / swapadd(l_run);
    LAS float* CB = (LAS float*)(lds + qs * 16384);
    if (m == 1) { const float f = -A.lam * linv;
#pragma unroll
        for (int e = 0; e < 4; ++e)
#pragma unroll
            for (int i = 0; i < 16; ++i) CB[(32 * e + crow(i, hh)) * 32 + r] = o[e][i] * f; }
    asm volatile("s_waitcnt lgkmcnt(0)" ::: "memory"); __builtin_amdgcn_s_barrier(); asm volatile("" ::: "memory");
    float ss = 0.f;
    if (m == 0) {
#pragma unroll
        for (int e = 0; e < 4; ++e)
#pragma unroll
            for (int i = 0; i < 16; ++i) { const float v = o[e][i] * linv + CB[(32 * e + crow(i, hh)) * 32 + r]; o[e][i] = v; ss += v * v; }
    }
    ss = swapadd(ss);
    asm volatile("s_waitcnt lgkmcnt(0)" ::: "memory"); __builtin_amdgcn_s_barrier(); asm volatile("" ::: "memory");
    LAS unsigned char* OS = lds + qs * 16384;
    if (m == 0) { const float rr = A.one_minus_lam_init / sqrtf(ss * (1.0f / 128.0f) + EPS);
        typedef float f32x2g __attribute__((ext_vector_type(2)));
#pragma unroll
        for (int e = 0; e < 4; ++e) { f32x2g gg[8];
#pragma unroll
            for (int i = 0; i < 16; i += 2) gg[i >> 1] = *(const GAS f32x2g*)(A.gain + 32 * e + crow(i, hh));
#pragma unroll
            for (int i = 0; i < 16; i += 2) { const int ee = 32 * e + crow(i, hh);
                *(LAS unsigned*)(OS + r * 264 + ee * 2) = pkbf(o[e][i] * rr * gg[i >> 1][0], o[e][i + 1] * rr * gg[i >> 1][1]); }
            asm volatile("" ::: "memory"); }
        asm volatile("s_waitcnt lgkmcnt(0)" ::: "memory");
        const int orow0 = b * SEQ + 128 * jb + 32 * qs;
#pragma unroll
        for (int k = 0; k < 8; ++k) { const int idx = k * 64 + lane, row = idx >> 4, ch = idx & 15;
            const unsigned long long lo = *(const LAS unsigned long long*)(OS + row * 264 + ch * 16), hi = *(const LAS unsigned long long*)(OS + row * 264 + ch * 16 + 8);
            u32x4 w; w.x = (unsigned)lo; w.y = (unsigned)(lo >> 32); w.z = (unsigned)hi; w.w = (unsigned)(hi >> 32);
            *(GAS u32x4*)(A.AO + (size_t)(orow0 + row) * D_MODEL + h * 128 + ch * 8) = w; }
    }
    asm volatile("s_waitcnt lgkmcnt(0)" ::: "memory"); __builtin_amdgcn_s_barrier(); asm volatile("" ::: "memory");
}
}
namespace mls {
using namespace cfg;
using att::f32x16; using att::s16x4; using att::u32x4; using att::crow; using att::swapadd; using att::vtr; using att::pkbf; using att::glds16;
constexpr int QI = 0, KI = 65536, VI = 98304, GT = 131072 + 1024;
struct MArgs { const bf16 *MQs, *MKs, *VMs, *OGs; bf16* AO; const float *A2, *C2, *MT, *gain; };

__device__ __forceinline__ void stage_k(const MArgs& A, LAS unsigned char* lds, int rowbase, int t, int h, int wave, int lane) {
#pragma unroll
    for (int i = 0; i < 4; ++i) { const int c = 4 * wave + i; int key = 64 * t + lane; key = key < T ? key : T - 1;
        glds16(A.MKs + (size_t)(rowbase + key) * 1024 + h * 256 + c * 8, lds + KI + c * 1024); }
}
__device__ __forceinline__ void stage_v(const MArgs& A, LAS unsigned char* lds, int rowbase, int t, int h, int wave, int lane) {
#pragma unroll
    for (int i = 0; i < 4; ++i) { const int p = 4 * wave + i, eb = p >> 2, rg = p & 3; int key = 64 * t + 16 * rg + (lane >> 2); key = key < T ? key : T - 1;
        glds16(A.VMs + (size_t)(rowbase + key) * 1024 + h * 256 + eb * 32 + (lane & 3) * 8, lds + VI + p * 1024); }
}

__device__ __forceinline__ void mlstm_unit(const MArgs& A, LAS unsigned char* lds, int b, int h, int jb, int tid, int wave, int lane) {
    const int qs = wave >> 1, eh = wave & 1, r = lane & 31, hh = lane >> 5, bh = b * N_HEADS_M + h;
    const int rowbase = b * T, q0 = N_META + 128 * jb, qp0 = q0 + 32 * qs, qpos = qp0 + r, NT = 2 * jb + 3;
    LAS float* c2s = (LAS float*)(lds + GT);
    for (int k = tid; k < 64 * NT; k += 512) c2s[k] = k < T ? A.C2[(size_t)bh * T + k] : -INFINITY;
    float a2q = A.A2[(size_t)bh * T + qpos], mq = A.MT[(size_t)bh * T + qpos];
    asm volatile("s_waitcnt vmcnt(0) lgkmcnt(0)" : "+v"(a2q), "+v"(mq) :: "memory");
#pragma unroll
    for (int i = 0; i < 8; ++i) { const int p = 8 * wave + i, c = p >> 1, rh = p & 1;
        glds16(A.MQs + (size_t)(rowbase + q0 + 64 * rh + lane) * 1024 + h * 256 + c * 8, lds + QI + c * 2048 + rh * 1024); }
    stage_k(A, lds, rowbase, 0, h, wave, lane); stage_v(A, lds, rowbase, 0, h, wave, lane);
    f32x16 o[4];
#pragma unroll
    for (int e = 0; e < 4; ++e)
#pragma unroll
        for (int i = 0; i < 16; ++i) o[e][i] = 0.f;
    float den = 0.f;
    const LAS unsigned char* qlane = lds + QI + hh * 2048 + (32 * qs + r) * 16;
    const LAS unsigned char* klane = lds + KI + hh * 1024 + r * 16;
    const LAS unsigned char* vlane = lds + VI + eh * 16384 + ((lane >> 4) & 1) * 32 + (lane & 3) * 8 + (4 * hh + ((lane & 15) >> 2)) * 64;
    for (int t = 0; t < NT; ++t) {
        asm volatile("s_waitcnt vmcnt(4)" ::: "memory");
        __builtin_amdgcn_s_barrier(); asm volatile("" ::: "memory");
        const bool act = 64 * t <= qp0 + 31;
        f32x16 p0, p1;
        if (act) {
#pragma unroll
            for (int i = 0; i < 16; ++i) { p0[i] = 0.f; p1[i] = 0.f; }
#pragma unroll
            for (int ds = 0; ds < 16; ++ds) { const bf16x8 qf = *(const LAS bf16x8*)(qlane + ds * 4096), k0 = *(const LAS bf16x8*)(klane + ds * 2048), k1 = *(const LAS bf16x8*)(klane + ds * 2048 + 512);
                p0 = ATT_MFMA(k0, qf, p0); p1 = ATT_MFMA(k1, qf, p1);
                if ((ds & 1) == 1) __builtin_amdgcn_sched_barrier(0); }
        }
        asm volatile("s_waitcnt lgkmcnt(0)" ::: "memory"); __builtin_amdgcn_s_barrier(); asm volatile("" ::: "memory");
        if (t + 1 < NT) stage_k(A, lds, rowbase, t + 1, h, wave, lane);
        u32x4 pf[4];
        if (act) {
            const LAS float* cc = c2s + 64 * t + 4 * hh; const bool diag = 64 * t + 63 > qp0;
#pragma unroll
            for (int g = 0; g < 4; ++g) { const f32x4 c0 = *(const LAS f32x4*)(cc + 8 * g), c1 = *(const LAS f32x4*)(cc + 32 + 8 * g);
#pragma unroll
                for (int j = 0; j < 4; ++j) { const int i = 4 * g + j, kp = 64 * t + crow(i, hh);
                    float w0 = p0[i] * __builtin_amdgcn_exp2f(a2q + c0[j]), w1 = p1[i] * __builtin_amdgcn_exp2f(a2q + c1[j]);
                    if (diag) { if (kp > qpos) w0 = 0.f; if (kp + 32 > qpos) w1 = 0.f; }
                    p0[i] = w0; p1[i] = w1; den += w0 + w1; } }
#pragma unroll
            for (int s = 0; s < 2; ++s) { pf[s] = (u32x4){pkbf(p0[8 * s], p0[8 * s + 1]), pkbf(p0[8 * s + 2], p0[8 * s + 3]), pkbf(p0[8 * s + 4], p0[8 * s + 5]), pkbf(p0[8 * s + 6], p0[8 * s + 7])};
                pf[2 + s] = (u32x4){pkbf(p1[8 * s], p1[8 * s + 1]), pkbf(p1[8 * s + 2], p1[8 * s + 3]), pkbf(p1[8 * s + 4], p1[8 * s + 5]), pkbf(p1[8 * s + 6], p1[8 * s + 7])}; }
        }
        if (t + 1 < NT) asm volatile("s_waitcnt vmcnt(4)" ::: "memory"); else asm volatile("s_waitcnt vmcnt(0)" ::: "memory");
        __builtin_amdgcn_s_barrier(); asm volatile("" ::: "memory");
        if (act) {
#pragma unroll
            for (int s = 0; s < 4; ++s) { __builtin_amdgcn_sched_barrier(0);
#pragma unroll
                for (int e = 0; e < 4; ++e) { const s16x4 lo = vtr(vlane + e * 4096 + s * 1024), hi = vtr(vlane + e * 4096 + s * 1024 + 512);
                    const bf16x8 vf = (bf16x8){lo[0], lo[1], lo[2], lo[3], hi[0], hi[1], hi[2], hi[3]};
                    o[e] = ATT_MFMA(vf, __builtin_bit_cast(bf16x8, pf[s]), o[e]); } }
        }
        asm volatile("s_waitcnt lgkmcnt(0)" ::: "memory"); __builtin_amdgcn_s_barrier(); asm volatile("" ::: "memory");
        if (t + 1 < NT) stage_v(A, lds, rowbase, t + 1, h, wave, lane);
    }
    den = swapadd(den);
    const float dinv = 1.0f / fmaxf(fabsf(den), __expf(-mq));
    float ss = 0.f;
#pragma unroll
    for (int e = 0; e < 4; ++e)
#pragma unroll
        for (int i = 0; i < 16; ++i) { o[e][i] *= dinv; ss += o[e][i] * o[e][i]; }
    ss = swapadd(ss);
    LAS float* XS = (LAS float*)(lds + GT);
    if (hh == 0) XS[wave * 32 + r] = ss;
    asm volatile("s_waitcnt lgkmcnt(0)" ::: "memory"); __builtin_amdgcn_s_barrier(); asm volatile("" ::: "memory");
    ss += XS[(wave ^ 1) * 32 + r];
    const float rr = 1.0f / sqrtf(ss * (1.0f / 256.0f) + EPS);
    LAS unsigned char* OS = lds + wave * 16384;
    typedef float f32x2g __attribute__((ext_vector_type(2)));
#pragma unroll
    for (int e = 0; e < 4; ++e) { f32x2g gg[8];
#pragma unroll
        for (int i = 0; i < 16; i += 2) gg[i >> 1] = *(const GAS f32x2g*)(A.gain + 128 * eh + 32 * e + crow(i, hh));
#pragma unroll
        for (int i = 0; i < 16; i += 2) { const int el = 32 * e + crow(i, hh);
            *(LAS unsigned*)(OS + r * 264 + el * 2) = pkbf(o[e][i] * rr * gg[i >> 1][0], o[e][i + 1] * rr * gg[i >> 1][1]); }
        asm volatile("" ::: "memory"); }
    asm volatile("s_waitcnt lgkmcnt(0)" ::: "memory");
    const int orow0 = b * SEQ + 128 * jb + 32 * qs;
    u32x4 ogv[8];
#pragma unroll
    for (int k = 0; k < 8; ++k) { const int idx = k * 64 + lane, row = idx >> 4, ch = idx & 15; ogv[k] = *(const GAS u32x4*)(A.OGs + (size_t)(rowbase + qp0 + row) * 1024 + h * 256 + eh * 128 + ch * 8); }
#pragma unroll
    for (int k = 0; k < 8; ++k) { const int idx = k * 64 + lane, row = idx >> 4, ch = idx & 15;
        const unsigned long long lo = *(const LAS unsigned long long*)(OS + row * 264 + ch * 16), hi = *(const LAS unsigned long long*)(OS + row * 264 + ch * 16 + 8);
        const u32x4 og = ogv[k];
        const unsigned hv[4] = {(unsigned)lo, (unsigned)(lo >> 32), (unsigned)hi, (unsigned)(hi >> 32)}; u32x4 w;
#pragma unroll
        for (int j = 0; j < 4; ++j) { const float h0 = __uint_as_float(hv[j] << 16), h1 = __uint_as_float(hv[j] & 0xffff0000u), g0 = __uint_as_float(og[j] << 16), g1 = __uint_as_float(og[j] & 0xffff0000u);
            w[j] = pkbf(h0 / (1.0f + __expf(-g0)), h1 / (1.0f + __expf(-g1))); }
        *(GAS u32x4*)(A.AO + (size_t)(orow0 + row) * D_MODEL + MLSTM_WIDTH + h * 256 + eh * 128 + ch * 8) = w; }
    asm volatile("s_waitcnt vmcnt(0) lgkmcnt(0)" ::: "memory"); __builtin_amdgcn_s_barrier(); asm volatile("" ::: "memory");
}

constexpr int CS_K = 0, CS_V = 8192, CS_BYTES = 40960;
__device__ __forceinline__ void cend_stage(const MArgs& A, LAS unsigned char* st, int rowbase, int t, int h, int dq, int wave, int lane) {
    { const int db = wave >> 2, rg = wave & 3; int key = 64 * t + 16 * rg + (lane >> 2); key = key < T ? key : T - 1;
      glds16(A.MKs + (size_t)(rowbase + key) * 1024 + h * 256 + dq * 64 + db * 32 + (lane & 3) * 8, st + CS_K + wave * 1024); }
#pragma unroll
    for (int i = 0; i < 4; ++i) { const int p = 4 * wave + i, eb = p >> 2, rg = p & 3; int key = 64 * t + 16 * rg + (lane >> 2); key = key < T ? key : T - 1;
        glds16(A.VMs + (size_t)(rowbase + key) * 1024 + h * 256 + eb * 32 + (lane & 3) * 8, st + CS_V + p * 1024); }
}
__device__ __forceinline__ void cend_unit(const MArgs& A, const float* BTM, float* outC, float* outN, LAS unsigned char* lds, int b, int h, int dq, int tid, int wave, int lane) {
    const int dsub = wave >> 2, eq = wave & 3, r = lane & 31, hh = lane >> 5, bh = b * N_HEADS_M + h, rowbase = b * T; constexpr int NT = (T + 63) / 64;
    LAS float* c2s = (LAS float*)(lds + GT);
    const float btm = BTM[bh];
    for (int k = tid; k < 64 * NT; k += 512) c2s[k] = k < T ? A.C2[(size_t)bh * T + k] + btm : -INFINITY;
    asm volatile("s_waitcnt vmcnt(0) lgkmcnt(0)" ::: "memory");
    f32x16 o[2], on;
#pragma unroll
    for (int i = 0; i < 16; ++i) { o[0][i] = 0.f; o[1][i] = 0.f; on[i] = 0.f; }
    const bf16x8 ones = (bf16x8){0x3f80, 0x3f80, 0x3f80, 0x3f80, 0x3f80, 0x3f80, 0x3f80, 0x3f80};
    const int tro = ((lane >> 4) & 1) * 32 + (lane & 3) * 8 + (4 * hh + ((lane & 15) >> 2)) * 64;
    cend_stage(A, lds, rowbase, 0, h, dq, wave, lane);
    for (int t = 0; t < NT; ++t) {
        LAS unsigned char* st = lds + (t & 1) * CS_BYTES;
        if (t + 1 < NT) { cend_stage(A, lds + ((t + 1) & 1) * CS_BYTES, rowbase, t + 1, h, dq, wave, lane); asm volatile("s_waitcnt vmcnt(5)" ::: "memory"); }
        else asm volatile("s_waitcnt vmcnt(0)" ::: "memory");
        __builtin_amdgcn_s_barrier(); asm volatile("" ::: "memory");
#pragma unroll
        for (int s = 0; s < 4; ++s) { __builtin_amdgcn_sched_barrier(0);
            const s16x4 klo = vtr(st + CS_K + dsub * 4096 + s * 1024 + tro), khi = vtr(st + CS_K + dsub * 4096 + s * 1024 + 512 + tro);
            const f32x4 w0 = *(const LAS f32x4*)(c2s + 64 * t + 16 * s + 4 * hh), w1 = *(const LAS f32x4*)(c2s + 64 * t + 16 * s + 8 + 4 * hh);
            u32x4 ks;
#pragma unroll
            for (int j = 0; j < 2; ++j) { ks[j] = pkbf(__uint_as_float((unsigned)(unsigned short)klo[2 * j] << 16) * __builtin_amdgcn_exp2f(w0[2 * j]), __uint_as_float((unsigned)(unsigned short)klo[2 * j + 1] << 16) * __builtin_amdgcn_exp2f(w0[2 * j + 1]));
                ks[2 + j] = pkbf(__uint_as_float((unsigned)(unsigned short)khi[2 * j] << 16) * __builtin_amdgcn_exp2f(w1[2 * j]), __uint_as_float((unsigned)(unsigned short)khi[2 * j + 1] << 16) * __builtin_amdgcn_exp2f(w1[2 * j + 1])); }
            const bf16x8 kf = __builtin_bit_cast(bf16x8, ks);
#pragma unroll
            for (int e = 0; e < 2; ++e) { const s16x4 lo = vtr(st + CS_V + (2 * eq + e) * 4096 + s * 1024 + tro), hi = vtr(st + CS_V + (2 * eq + e) * 4096 + s * 1024 + 512 + tro);
                const bf16x8 vf = (bf16x8){lo[0], lo[1], lo[2], lo[3], hi[0], hi[1], hi[2], hi[3]};
                o[e] = ATT_MFMA(kf, vf, o[e]); }
            on = ATT_MFMA(kf, ones, on); }
        asm volatile("s_waitcnt lgkmcnt(0)" ::: "memory"); __builtin_amdgcn_s_barrier(); asm volatile("" ::: "memory");
    }
    const int d0 = dq * 64 + dsub * 32;
#pragma unroll
    for (int e = 0; e < 2; ++e)
#pragma unroll
        for (int i = 0; i < 16; ++i) outC[((size_t)bh * HEAD_DIM_M + d0 + crow(i, hh)) * HEAD_DIM_M + eq * 64 + e * 32 + r] = o[e][i];
    if (eq == 0 && r == 0) {
#pragma unroll
        for (int i = 0; i < 16; ++i) outN[(size_t)bh * HEAD_DIM_M + d0 + crow(i, hh)] = on[i]; }
    asm volatile("s_waitcnt vmcnt(0)" ::: "memory"); __builtin_amdgcn_s_barrier(); asm volatile("" ::: "memory");
}
}
namespace dec {
using namespace cfg;
__device__ __forceinline__ float bfu(unsigned short h) { return __uint_as_float((unsigned)h << 16); }
__device__ __forceinline__ float sigm(float x) { return 1.0f / (1.0f + __expf(-x)); }
__device__ __forceinline__ float logsig(float x) { return fminf(x, 0.f) - log1pf(expf(-fabsf(x))); }
constexpr int NSEQ_ = BATCH * T;
constexpr int NSPLIT = 32, PPS = N_PAGES / NSPLIT;
constexpr int NROW = 2 * DEC_SEQ;
static_assert(NROW == 8 && V_DIM_A == 128 && N_HEADS_A == 8, "decode lane layout");
constexpr size_t PO_FLOATS = (size_t)DEC_BATCH * NSPLIT * N_HEADS_A * NROW * V_DIM_A, PML_FLOATS = (size_t)DEC_BATCH * NSPLIT * N_HEADS_A * NROW * 2;
template <int CTRL> __device__ __forceinline__ float dpp(float x) { return __builtin_bit_cast(float, __builtin_amdgcn_mov_dpp(__builtin_bit_cast(int, x), CTRL, 0xf, 0xf, true)); }
__device__ __forceinline__ float row16_sum(float x) { x += dpp<0xB1>(x); x += dpp<0x4E>(x); x += dpp<0x141>(x); x += dpp<0x128>(x); return x; }
__device__ __forceinline__ float x4_max(float x) { auto s = __builtin_amdgcn_permlane16_swap(__float_as_uint(x), __float_as_uint(x), false, false); x = fmaxf(__uint_as_float(s[0]), __uint_as_float(s[1]));
    auto t = __builtin_amdgcn_permlane32_swap(__float_as_uint(x), __float_as_uint(x), false, false); return fmaxf(__uint_as_float(t[0]), __uint_as_float(t[1])); }
__device__ __forceinline__ float x4_sum(float x) { auto s = __builtin_amdgcn_permlane16_swap(__float_as_uint(x), __float_as_uint(x), false, false); x = __uint_as_float(s[0]) + __uint_as_float(s[1]);
    auto t = __builtin_amdgcn_permlane32_swap(__float_as_uint(x), __float_as_uint(x), false, false); return __uint_as_float(t[0]) + __uint_as_float(t[1]); }
struct DArgs { const float *ck, *cv; const int* pt; const bf16* smp; float *PO, *PML; };
typedef short bf16x8d __attribute__((ext_vector_type(8)));
typedef short s16x4d __attribute__((ext_vector_type(4)));
typedef unsigned u32x2d __attribute__((ext_vector_type(2)));
using att::u32x4;
#define DEC_MFMA(a, b, c) __builtin_amdgcn_mfma_f32_16x16x32_bf16((a), (b), (c), 0, 0, 0)
__device__ __forceinline__ void decode_unit(const DArgs& A, LAS unsigned char* lds, int bd, int sp, int wave, int lane) {
    const int h = wave, i16 = lane & 15, kq = lane >> 4; constexpr int NBLK = PPS * PAGE_SIZE / 32;
    const int row = i16, mrow = row >> 2, qrow = row & 3;
    const float sl2 = exp2f(-8.0f * (float)(h + 1) / (float)N_HEADS_A) * 1.4426950408889634f;
    LAS unsigned char* Kimg = lds + wave * 16384; LAS unsigned char* Vimg = Kimg + 8192;
    bf16x8d qf[4];
#pragma unroll
    for (int ks = 0; ks < 4; ++ks) { const int d0 = 32 * ks + 8 * kq; u32x4 w = (u32x4){0u, 0u, 0u, 0u};
        if (row < NROW && (d0 >> 6) == mrow) w = *(const GAS u32x4*)(A.smp + (size_t)(bd * DEC_SEQ + qrow) * 1024 + h * 128 + d0);
        qf[ks] = __builtin_bit_cast(bf16x8d, w); }
    const int st_k = lane >> 5, st_c = lane & 31;
    const unsigned lane_ob = (unsigned)((st_k * ATT_WIDTH + h * 128 + 4 * st_c) * 4);
    constexpr int N_POOL_ = DEC_BATCH * N_PAGES * 5 / 4; static_assert((long long)N_POOL_ * PAGE_SIZE * ATT_WIDTH * 4 < (1ll << 31), "cache byte offsets fit 31 bits");
    const __amdgpu_buffer_rsrc_t rk = __builtin_amdgcn_make_buffer_rsrc((void*)A.ck, 0, N_POOL_ * PAGE_SIZE * ATT_WIDTH * 4, 0x00020000), rv = __builtin_amdgcn_make_buffer_rsrc((void*)A.cv, 0, N_POOL_ * PAGE_SIZE * ATT_WIDTH * 4, 0x00020000);
    f32x4 kr[16], vr[16];
#define DEC_LOADX(blk, rs, reg, lo_, hi_) do { const int b_ = (blk), pg_ = __builtin_amdgcn_readfirstlane(A.pt[bd * N_PAGES + sp * PPS + (b_ >> 2)]); \
        const int so_ = pg_ * (PAGE_SIZE * ATT_WIDTH * 4) + ((b_ & 3) * 32) * (ATT_WIDTH * 4); \
        _Pragma("unroll") for (int i = (lo_); i < (hi_); ++i) reg[i] = __builtin_bit_cast(f32x4, __builtin_amdgcn_raw_buffer_load_b128((rs), (int)lane_ob, so_ + (2 * i) * (ATT_WIDTH * 4), 2)); } while (0)
    DEC_LOADX(0, rk, kr, 0, 16); DEC_LOADX(0, rv, vr, 0, 16);
    f32x4 o[8];
#pragma unroll
    for (int e = 0; e < 8; ++e) o[e] = (f32x4){0.f, 0.f, 0.f, 0.f};
    float m_run = -1e30f, l_run = 0.f;
    const int kchunk = st_c >> 1, ksub = st_c & 1;
    LAS unsigned char *kwb[4], *vwb[4]; const LAS unsigned char *krb[2], *vrb[8];
#pragma unroll
    for (int j = 0; j < 4; ++j) { const int k7 = 2 * j + st_k; kwb[j] = Kimg + kchunk * 512 + ((k7 ^ (kchunk & 7)) * 16) + ksub * 8; vwb[j] = Vimg + k7 * 256 + ((st_c ^ (4 * k7)) * 8); }
#pragma unroll
    for (int e = 0; e < 2; ++e) krb[e] = Kimg + kq * 512 + ((i16 ^ (4 * e + kq)) * 16);
    { const int ra = 4 * kq + (i16 >> 2), pp = i16 & 3;
#pragma unroll
      for (int et = 0; et < 8; ++et) vrb[et] = Vimg + ra * 256 + (((4 * et + pp) ^ (4 * (ra & 7))) * 8); }
    const LAS unsigned char* kfr = Kimg + kq * 512;
    for (int blk = 0; blk < NBLK; ++blk) {
        asm volatile("s_waitcnt lgkmcnt(0)" ::: "memory");
#pragma unroll
        for (int i = 0; i < 16; ++i) {
            u32x2d kw; kw.x = att::pkbf(kr[i][0], kr[i][1]); kw.y = att::pkbf(kr[i][2], kr[i][3]);
            *(LAS u32x2d*)(kwb[i & 3] + (i >> 2) * 128) = kw; }
        asm volatile("" ::: "memory");
        if (blk + 1 < NBLK) DEC_LOADX(blk + 1, rk, kr, 0, 16);
        asm volatile("" ::: "memory");
        asm volatile("s_waitcnt lgkmcnt(0)" ::: "memory");
        const float kp = (float)(sp * PPS * PAGE_SIZE + blk * 32 + 4 * kq - PAST_LEN - qrow);
        f32x4 p0, p1;
#pragma unroll
        for (int t = 0; t < 4; ++t) { p0[t] = sl2 * (kp + (float)t); p1[t] = sl2 * (kp + (float)(16 + t)); }
#pragma unroll
        for (int ks = 0; ks < 4; ++ks) {
            const bf16x8d k0 = *(const LAS bf16x8d*)(krb[ks & 1] + ks * 2048), k1 = *(const LAS bf16x8d*)(krb[ks & 1] + ks * 2048 + 256);
            p0 = DEC_MFMA(k0, qf[ks], p0); p1 = DEC_MFMA(k1, qf[ks], p1); }
        float mx = fmaxf(fmaxf(fmaxf(p0[0], p0[1]), fmaxf(p0[2], p0[3])), fmaxf(fmaxf(p1[0], p1[1]), fmaxf(p1[2], p1[3])));
        mx = x4_max(mx);
        if (__any(mx > m_run)) { const float mn = fmaxf(m_run, mx), al = __builtin_amdgcn_exp2f(m_run - mn); m_run = mn; l_run *= al;
#pragma unroll
            for (int e = 0; e < 8; ++e) o[e] = o[e] * al; }
#pragma unroll
        for (int t = 0; t < 4; ++t) { p0[t] = __builtin_amdgcn_exp2f(p0[t] - m_run); p1[t] = __builtin_amdgcn_exp2f(p1[t] - m_run); }
        l_run += (p0[0] + p0[1]) + (p0[2] + p0[3]) + (p1[0] + p1[1]) + (p1[2] + p1[3]);
        const u32x4 pw = (u32x4){att::pkbf(p0[0], p0[1]), att::pkbf(p0[2], p0[3]), att::pkbf(p1[0], p1[1]), att::pkbf(p1[2], p1[3])};
        const bf16x8d pf = __builtin_bit_cast(bf16x8d, pw);
        asm volatile("" ::: "memory");
#pragma unroll
        for (int i = 0; i < 16; ++i) {
            u32x2d vw; vw.x = att::pkbf(vr[i][0], vr[i][1]); vw.y = att::pkbf(vr[i][2], vr[i][3]);
            *(LAS u32x2d*)(vwb[i & 3] + (i >> 2) * 2048) = vw; }
        asm volatile("" ::: "memory");
        if (blk + 1 < NBLK) DEC_LOADX(blk + 1, rv, vr, 0, 16);
        asm volatile("" ::: "memory");
        asm volatile("s_waitcnt lgkmcnt(0)" ::: "memory");
        asm volatile("" ::: "memory");
#pragma unroll
        for (int et = 0; et < 8; ++et) {
            const s16x4d lo = __builtin_bit_cast(s16x4d, __builtin_amdgcn_ds_read_tr16_b64_v4i16((LAS att::v4i16_t*)(vrb[et])));
            const s16x4d hi = __builtin_bit_cast(s16x4d, __builtin_amdgcn_ds_read_tr16_b64_v4i16((LAS att::v4i16_t*)(vrb[et] + 4096)));
            const bf16x8d vf = (bf16x8d){lo[0], lo[1], lo[2], lo[3], hi[0], hi[1], hi[2], hi[3]};
            o[et] = DEC_MFMA(vf, pf, o[et]); }
        asm volatile("" ::: "memory");
    }
#undef DEC_LOADX
    const float lt = x4_sum(l_run);
    const __amdgpu_buffer_rsrc_t rpo = __builtin_amdgcn_make_buffer_rsrc((void*)A.PO, 0, (int)(PO_FLOATS * 4), 0x00020000);
    const int ln2 = lane_now(); const int row2 = ln2 & 15, kq2 = ln2 >> 4;
    if (row2 < NROW) { const unsigned ub = (unsigned)(((bd * NSPLIT + sp) * N_HEADS_A + h) * NROW + row2);
#pragma unroll
        for (int et = 0; et < 8; ++et) __builtin_amdgcn_raw_buffer_store_b128(__builtin_bit_cast(u32x4, o[et]), rpo, (int)((ub * V_DIM_A + 16 * et + 4 * kq2) * 4u), 0, 16);
        if (kq2 == 0) { __hip_atomic_store(A.PML + ub * 2, m_run, __ATOMIC_RELAXED, __HIP_MEMORY_SCOPE_AGENT); __hip_atomic_store(A.PML + ub * 2 + 1, lt, __ATOMIC_RELAXED, __HIP_MEMORY_SCOPE_AGENT); } }
}
struct CArgs { const float *PO, *PML; const bf16* smp; bf16* AOs; const float* gain; float lam, oml; };
__device__ __forceinline__ float wsum(float v) { return x4_sum(row16_sum(v)); }
__device__ __forceinline__ void decode_combine(const CArgs& A, int bd, int h, int q, int lane) {
    const float sl2 = exp2f(-8.0f * (float)(h + 1) / (float)N_HEADS_A) * 1.4426950408889634f; constexpr size_t SB = (size_t)R_SAMPLE * 1024;
    static_assert(NSPLIT == 32, "lane-parallel statistics");
    float res0 = 0.f, res1 = 0.f;
#pragma unroll
    for (int m = 0; m < 2; ++m) { const int j = m * DEC_SEQ + q;
        float sn[DEC_SEQ]; const float qd = bfu(A.smp[(size_t)(bd * DEC_SEQ + q) * 1024 + h * 128 + m * 64 + lane]);
#pragma unroll
        for (int t = 0; t < DEC_SEQ; ++t) { const float kd = bfu(A.smp[SB + (size_t)(bd * DEC_SEQ + t) * 1024 + h * 128 + m * 64 + lane]); sn[t] = t <= q ? wsum(qd * kd) + sl2 * (float)(t - q) : -INFINITY; }
        const int sl = lane & 31; const size_t ubl = (((size_t)(bd * NSPLIT + sl)) * N_HEADS_A + h) * NROW + j;
        const float ms = A.PML[ubl * 2], ls = A.PML[ubl * 2 + 1];
        float M = ms;
#pragma unroll
        for (int o = 1; o < 32; o <<= 1) M = fmaxf(M, __shfl_xor(M, o));
#pragma unroll
        for (int t = 0; t < DEC_SEQ; ++t) M = fmaxf(M, sn[t]);
        const float fs = __builtin_amdgcn_exp2f(ms - M); float L = (lane < 32) ? ls * fs : 0.f; L = wsum(L);
        float o0 = 0.f, o1 = 0.f;
#pragma unroll 8
        for (int s = 0; s < NSPLIT; ++s) { const size_t ub = (((size_t)(bd * NSPLIT + s)) * N_HEADS_A + h) * NROW + j; const float f = __shfl(fs, s);
            o0 += A.PO[ub * V_DIM_A + lane] * f; o1 += A.PO[ub * V_DIM_A + 64 + lane] * f; }
#pragma unroll
        for (int t = 0; t < DEC_SEQ; ++t) { const float p = __builtin_amdgcn_exp2f(sn[t] - M); L += p;
            o0 += p * bfu(A.smp[2 * SB + (size_t)(bd * DEC_SEQ + t) * 1024 + h * 128 + lane]); o1 += p * bfu(A.smp[2 * SB + (size_t)(bd * DEC_SEQ + t) * 1024 + h * 128 + 64 + lane]); }
        const float sc = (m ? -A.lam : 1.0f) / L; res0 += o0 * sc; res1 += o1 * sc; }
    const float ss = wsum(res0 * res0 + res1 * res1), rr = A.oml / sqrtf(ss * (1.0f / 128.0f) + EPS);
    bf16* o = A.AOs + (size_t)(bd * DEC_SEQ + q) * D_MODEL + h * 128; o[lane] = (bf16)f2bf(res0 * rr * A.gain[lane]); o[64 + lane] = (bf16)f2bf(res1 * rr * A.gain[64 + lane]);
}
struct SArgs { const float *stC, *stN, *stM, *GATES, *gate_bias, *gain; const bf16* smp; bf16* AOs; float *oC, *oN, *oM; };
__device__ __forceinline__ void sample_mlstm_unit(const SArgs& A, LAS float* sm, int bd, int h, int tid, int wave, int lane) {
    constexpr int L = DEC_SEQ, Dh = HEAD_DIM_M; const int bh = bd * N_HEADS_M + h; constexpr size_t SB = (size_t)R_SAMPLE * 1024;
    LAS float* q_ = sm; LAS float* k_ = sm + L * Dh; LAS float* v_ = sm + 2 * L * Dh; LAS float* wk_ = sm + 3 * L * Dh;
    LAS float* qc_ = sm + 4 * L * Dh;
    LAS float* sc_ = sm + 6 * L * Dh;
    float bb[L], ii[L], mm[L]; const float m0 = A.stM[bh]; { float B = 0.f, m = m0;
#pragma unroll
        for (int t = 0; t < L; ++t) { const float* g = A.GATES + ((size_t)NSEQ_ + bd * L + t) * 8; const float ig = g[h] + A.gate_bias[h], lf = logsig(g[4 + h] + A.gate_bias[N_HEADS_M + h]); B += lf; m = fmaxf(lf + m, ig); bb[t] = B; ii[t] = ig; mm[t] = m; } }
    const float mE = mm[L - 1], bL = bb[L - 1], w_c = __expf(bL + m0 - mE);
    for (int i = tid; i < L * Dh; i += 512) { const int t = i / Dh, d = i % Dh; const size_t o = (size_t)(bd * L + t) * 1024 + h * Dh + d;
        q_[i] = bfu(A.smp[6 * SB + o]); const float kv = bfu(A.smp[7 * SB + o]); k_[i] = kv; v_[i] = bfu(A.smp[4 * SB + o]);
        float ws = 0.f;
#pragma unroll
        for (int s = 0; s < L; ++s) if (s == t) ws = __expf(bL - bb[s] + ii[s] - mE);
        wk_[i] = ws * kv; }
    __syncthreads();
    for (int dIdx = wave; dIdx < L * L + L; dIdx += 8) { float a = 0.f;
        if (dIdx < L * L) { const int t = dIdx / L, s = dIdx % L; for (int d = lane; d < Dh; d += 64) a += q_[t * Dh + d] * k_[s * Dh + d]; }
        else { const int t = dIdx - L * L; for (int d = lane; d < Dh; d += 64) a += q_[t * Dh + d] * A.stN[(size_t)bh * Dh + d]; }
        a = wsum(a); if (lane == 0) sc_[dIdx] = a; }
    { const int e = tid & (Dh - 1), dh = tid >> 8; float qc[L];
#pragma unroll
      for (int t = 0; t < L; ++t) qc[t] = 0.f;
      const float* C0 = A.stC + (size_t)bh * Dh * Dh; float* Co = A.oC + (size_t)bh * Dh * Dh; float ve[L];
#pragma unroll
      for (int s = 0; s < L; ++s) ve[s] = v_[s * Dh + e];
      for (int d = dh * (Dh / 2); d < (dh + 1) * (Dh / 2); ++d) { const float cv = C0[(size_t)d * Dh + e]; float cn = w_c * cv;
#pragma unroll
          for (int t = 0; t < L; ++t) { qc[t] += q_[t * Dh + d] * cv; cn += wk_[t * Dh + d] * ve[t]; }
          Co[(size_t)d * Dh + e] = cn; }
#pragma unroll
      for (int t = 0; t < L; ++t) qc_[(dh * L + t) * Dh + e] = qc[t]; }
    if (tid < Dh) { float nn = w_c * A.stN[(size_t)bh * Dh + tid];
#pragma unroll
        for (int s = 0; s < L; ++s) nn += wk_[s * Dh + tid];
        A.oN[(size_t)bh * Dh + tid] = nn; }
    if (tid == 0) A.oM[bh] = mE;
    __syncthreads();
    { const int e = tid & (Dh - 1), hf = tid >> 8; float hv[2];
#pragma unroll
      for (int u = 0; u < 2; ++u) { const int t = 2 * hf + u; float bt = 0.f, mt = 0.f;
#pragma unroll
          for (int s = 0; s < L; ++s) if (s == t) { bt = bb[s]; mt = mm[s]; }
          const float wi = __expf(bt + m0 - mt); float num = wi * (qc_[t * Dh + e] + qc_[(L + t) * Dh + e]), den = wi * sc_[L * L + t];
#pragma unroll
          for (int s = 0; s < L; ++s) if (s <= t) { const float sv = sc_[t * L + s] * __expf(bt - bb[s] + ii[s] - mt); den += sv; num += sv * v_[s * Dh + e]; }
          hv[u] = num / fmaxf(fabsf(den), __expf(-mt)); }
      LAS float* red = sc_ + L * L + L;
      const float s0 = wsum(hv[0] * hv[0]), s1 = wsum(hv[1] * hv[1]); if (lane == 0) { red[wave * 2] = s0; red[wave * 2 + 1] = s1; }
      __syncthreads();
#pragma unroll
      for (int u = 0; u < 2; ++u) { const int t = 2 * hf + u; float ss = 0.f;
#pragma unroll
          for (int w = 0; w < 4; ++w) ss += red[(hf * 4 + w) * 2 + u];
          const float rr = 1.0f / sqrtf(ss * (1.0f / Dh) + EPS); const size_t o = (size_t)(bd * L + t) * 1024 + h * Dh + e;
          A.AOs[(size_t)(bd * L + t) * D_MODEL + MLSTM_WIDTH + h * Dh + e] = (bf16)f2bf(hv[u] * rr * A.gain[e] * sigm(bfu(A.smp[5 * SB + o]))); } }
    __syncthreads();
}
}
namespace mk {
using namespace cfg;
constexpr int NWAVES = 8, NTHREADS = NWAVES * 64, GRID = 256;
constexpr size_t MiB = 1u << 20;
constexpr size_t FAST_BASE = 0;
constexpr size_t WS_CTL = 0, CTL_ZERO_BYTES = 128 * 1024;
constexpr size_t al_(size_t x) { return (x + 65535) / 65536 * 65536; }
constexpr int NSEQ = BATCH * T;
constexpr size_t WS_WIN = 1 * MiB;
constexpr size_t WS_WOUT = WS_WIN + al_((size_t)6144 * D_MODEL * 2);
constexpr size_t WS_WUP = WS_WOUT + al_((size_t)D_MODEL * D_MODEL * 2);
constexpr size_t WS_WDOWN = WS_WUP + al_((size_t)D_FF * D_MODEL * 2);
constexpr size_t WS_XN = WS_WDOWN + al_((size_t)D_FF * D_MODEL * 2);
constexpr size_t WS_XNS = WS_XN + al_((size_t)R_PROMPT * D_MODEL * 2);
constexpr size_t WS_GATES = WS_XNS + al_((size_t)64 * D_MODEL * 2);
constexpr size_t WS_QS = WS_GATES + al_((size_t)(NSEQ + R_SAMPLE) * 8 * 4);
constexpr size_t SEQB = al_((size_t)NSEQ * 1024 * 2);
constexpr size_t WS_KS = WS_QS + SEQB, WS_VS = WS_KS + SEQB, WS_US = WS_VS + SEQB, WS_VMS = WS_US + SEQB, WS_OGS = WS_VMS + SEQB;
constexpr size_t WS_UAS = WS_OGS + SEQB, WS_MQS = WS_UAS + SEQB, WS_MKS = WS_MQS + SEQB;
constexpr size_t WS_SMP = WS_MKS + SEQB, SMPB = (size_t)R_SAMPLE * 1024 * 2;
constexpr size_t WS_UAT = WS_SMP + al_(8 * SMPB);
constexpr size_t WS_WQK = WS_UAT + al_((size_t)64 * 1024 * 2);
constexpr size_t WS_SCAN = WS_WQK + al_((size_t)N_HEADS_M * 2 * HEAD_DIM_M * HEAD_DIM_M * 2);
constexpr size_t SCANN = (size_t)BATCH * N_HEADS_M * T;
constexpr size_t WS_PO = WS_SCAN + al_((3 * SCANN + 64) * 4);
constexpr size_t WS_PML = WS_PO + al_(dec::PO_FLOATS * 4);
constexpr size_t WS_AOS = WS_PML + al_(dec::PML_FLOATS * 4);
constexpr size_t WS_X1S = WS_AOS + al_((size_t)R_SAMPLE * D_MODEL * 2);
constexpr size_t WS_XN2S = WS_X1S + al_((size_t)R_SAMPLE * D_MODEL * 4);
constexpr size_t WS_SSQS = WS_XN2S + al_((size_t)R_SAMPLE * D_MODEL * 2);
constexpr size_t WS_HS = WS_SSQS + al_((size_t)R_SAMPLE * 128 * 4);
constexpr size_t WS_AO = WS_HS + al_((size_t)R_SAMPLE * D_FF * 2);
constexpr size_t WS_XN2 = WS_AO + al_((size_t)R_PROMPT * D_MODEL * 2);
constexpr size_t WS_H = WS_XN2 + al_((size_t)R_PROMPT * D_MODEL * 2);
constexpr size_t WS_SSQ = WS_H + al_((size_t)R_PROMPT * D_FF * 2);
constexpr size_t WS_FAST_END = WS_SSQ + al_((size_t)R_PROMPT * 8 * 4);
constexpr float QSCALE = 0.125f * 1.4426950408889634f;
constexpr int CW_TMO = 0, CW_BAR = 4096, CW_DECQ = 16384, CW_QKC = CW_DECQ + 64 * 48, CW_DECC = CW_QKC + 64, CW_PQ = CW_DECC + 64;
constexpr int CW_DECQ_ = CW_DECQ;
static_assert((CW_BAR + 2 * 3456) <= CW_DECQ && (CW_PQ + 64) * 4 <= (int)CTL_ZERO_BYTES, "ctl words");
constexpr int RING_OFF = 0, RING_BYTES = 131072, LDSCTL_OFF = RING_BYTES, MISC_OFF = LDSCTL_OFF + 320, LDS_BYTES = 147456;

struct Args {
    const float *x_prompt, *x_sample, *meta, *norm_mix, *w_in, *q_norm, *k_norm, *lambda_qk, *attn_out_norm, *conv_w, *conv_b, *w_qm, *w_km, *gate_bias, *state_conv, *mlstm_out_norm, *cache_k, *cache_v, *state_C, *state_n, *state_m, *w_out, *norm_ffn, *w_up, *w_down, *ao_f32; const int* page_table; float* out; unsigned char* fws;
    int ph_lo, ph_hi, li, pad;
};
struct Frame { LAS unsigned char* lds; volatile LAS unsigned* MISC; int tid, lane, wave, vcu, G; };

__device__ __forceinline__ float wave_sum(float v) { return dec::x4_sum(dec::row16_sum(v)); }
__device__ __forceinline__ void p0_transpose_item(const float* W, int ldw, int K, int N, bf16* WT, LAS float* scr, int item, int lane, float scale = 1.0f) {
    const int nblk = N / 32, kb = item / nblk, nb = item % nblk, k0 = 64 * kb, n0 = 32 * nb;
    { const GAS f32x4* src = (const GAS f32x4*)(W + (size_t)(k0 + lane) * ldw + n0); f32x4 v[8];
#pragma unroll
      for (int i = 0; i < 8; ++i) v[i] = src[i];
#pragma unroll
      for (int i = 0; i < 8; ++i) { scr[lane * 33 + 4 * i] = v[i][0]; scr[lane * 33 + 4 * i + 1] = v[i][1]; scr[lane * 33 + 4 * i + 2] = v[i][2]; scr[lane * 33 + 4 * i + 3] = v[i][3]; } }
    LDS_WAIT(); asm volatile("" ::: "memory");
    const int c = lane & 7;
#pragma unroll
    for (int j = 0; j < 4; ++j) { const int n = (lane >> 3) + 8 * j; const LAS float* s = scr + (8 * c) * 33 + n;
        v4u o; o.x = pk2(s[0 * 33] * scale, s[1 * 33] * scale); o.y = pk2(s[2 * 33] * scale, s[3 * 33] * scale); o.z = pk2(s[4 * 33] * scale, s[5 * 33] * scale); o.w = pk2(s[6 * 33] * scale, s[7 * 33] * scale);
        *(GAS v4u*)(WT + (size_t)(n0 + n) * K + k0 + 8 * c) = o; }
    LDS_WAIT(); asm volatile("" ::: "memory");
}
__device__ __forceinline__ void cvt_rows_bf16(const float* src, bf16* dst, size_t n8, int gw, int NGW, int lane) {
    for (size_t i = (size_t)gw * 64 + lane; i < n8; i += (size_t)NGW * 64) { const f32x4 a = *(const GAS f32x4*)(src + i * 8), b = *(const GAS f32x4*)(src + i * 8 + 4);
        v4u o; o.x = pk2(a[0], a[1]); o.y = pk2(a[2], a[3]); o.z = pk2(b[0], b[1]); o.w = pk2(b[2], b[3]); *(GAS v4u*)(dst + i * 8) = o; }
}

__device__ __forceinline__ void p0_row(const float* x_prompt, const float* x_sample, const float* meta, const f32x4 (&nmix)[8], int r, bf16* XNb, bf16* XNs, float* GATES, const LAS float* WgT, int lane) {
    const float* x = r < R_PROMPT ? x_prompt + (size_t)r * D_MODEL : r < R_FULL ? x_sample + (size_t)(r - R_PROMPT) * D_MODEL : meta + (size_t)(r - R_FULL) * D_MODEL;
    const GAS f32x4* xr = (const GAS f32x4*)x + lane; f32x4 v[8]; float s = 0.f;
#pragma unroll
    for (int j = 0; j < 8; ++j) { v[j] = xr[64 * j]; s += (v[j][0] * v[j][0] + v[j][1] * v[j][1]) + (v[j][2] * v[j][2] + v[j][3] * v[j][3]); }
    const float rstd = 1.0f / sqrtf(wave_sum(s) * (1.0f / D_MODEL) + EPS);
    bf16* orow = r < R_PROMPT ? XNb + (size_t)r * D_MODEL : XNs + (size_t)(r - R_PROMPT) * D_MODEL;
    GAS unsigned long long* o8 = (GAS unsigned long long*)orow + lane;
#pragma unroll
    for (int j = 0; j < 8; ++j) { v[j] = v[j] * rstd * nmix[j];
        o8[64 * j] = (unsigned long long)pk2(v[j][0], v[j][1]) | ((unsigned long long)pk2(v[j][2], v[j][3]) << 32); }
    float ga[8];
#pragma unroll
    for (int g = 0; g < 8; ++g) { float a = 0.f;
#pragma unroll
        for (int j = 0; j < 8; ++j) { const f32x4 w = *(const LAS f32x4*)(WgT + g * D_MODEL + 256 * j + 4 * lane); a += (v[j][0] * w[0] + v[j][1] * w[1]) + (v[j][2] * w[2] + v[j][3] * w[3]); }
        ga[g] = wave_sum(a); asm volatile("" ::: "memory"); }
    float mine = 0.f;
#pragma unroll
    for (int g = 0; g < 8; ++g) mine = (lane & 7) == g ? ga[g] : mine;
    if (r < R_PROMPT) { if (lane < 8) GATES[((size_t)(r / SEQ) * T + N_META + r % SEQ) * 8 + lane] = mine; }
    else if (r < R_FULL) { if (lane < 8) GATES[((size_t)NSEQ + (r - R_PROMPT)) * 8 + lane] = mine; }
    else { if (lane < 8 * BATCH) GATES[((size_t)(lane >> 3) * T + (r - R_FULL)) * 8 + (lane & 7)] = mine; }
}

template <int MT, int NTW, int KS>
__device__ __forceinline__ void skinny_gemm(const bf16* X, int lda, const bf16* Wt, int ldb, int n0, int K, LAS float* red, LAS float* z, int tid, int wave, int lane) {
    static_assert(NTW * KS == NWAVES, "8 waves");
    const int nt = wave % NTW, ks = wave / NTW, kq = lane >> 4, i16 = lane & 15, klen = K / KS, k0 = ks * klen;
    f32x4 acc[MT];
#pragma unroll
    for (int mt = 0; mt < MT; ++mt) acc[mt] = (f32x4){0.f, 0.f, 0.f, 0.f};
    const bf16* wp = Wt + (size_t)(n0 + 16 * nt + i16) * ldb + k0 + 8 * kq;
    const bf16* xp = X + (size_t)i16 * lda + k0 + 8 * kq;
#pragma unroll 8
    for (int k = 0; k < klen; k += 32) {
        const bf16x8 wf = *(const GAS bf16x8*)(wp + k);
#pragma unroll
        for (int mt = 0; mt < MT; ++mt) { const bf16x8 xf = *(const GAS bf16x8*)(xp + (size_t)mt * 16 * lda + k); acc[mt] = __builtin_amdgcn_mfma_f32_16x16x32_bf16(wf, xf, acc[mt], 0, 0, 0); }
    }
#pragma unroll
    for (int mt = 0; mt < MT; ++mt) *(LAS f32x4*)(red + ((ks * NTW + nt) * MT + mt) * 256 + lane * 4) = acc[mt];
    __syncthreads();
    constexpr int ZW = NTW * 16 + 4;
    for (int e = tid; e < MT * 16 * NTW * 16; e += NTHREADS) { const int m = e / (NTW * 16), n = e % (NTW * 16), nt_ = n >> 4, nl = n & 15, mt_ = m >> 4, ml = m & 15; float sum = 0.f;
#pragma unroll
        for (int q = 0; q < KS; ++q) sum += red[((q * NTW + nt_) * MT + mt_) * 256 + (ml + 16 * (nl >> 2)) * 4 + (nl & 3)];
        z[m * ZW + n] = sum; }
    __syncthreads();
}
struct TailBufs { bf16 *Ks, *Vs, *Us, *VMs, *smp; float* out; const float *q_g, *k_g; };
__device__ __forceinline__ void inproj_tail_epi(const TailBufs& B, const LAS float* z, int g, int wave, int lane) {
    const int typ = g >> 4, c = (g & 15) * 64 + lane;
    for (int r = wave; r < 48; r += NWAVES) {
        float v = z[r * 68 + lane];
        if (typ <= 1) { const float ss = wave_sum(v * v); v = v * (1.0f / sqrtf(ss * (1.0f / 64.0f) + EPS)) * (typ ? B.k_g : B.q_g)[lane]; }
        if (r < R_SAMPLE) {
            const int bd = r / DEC_SEQ, ts = r % DEC_SEQ;
            if (typ == 1) B.out[O_KS + (size_t)r * 1024 + c] = v;
            if (typ == 2) B.out[O_VS + (size_t)r * 1024 + c] = v;
            if (typ == 3 && ts >= DEC_SEQ - 3) B.out[O_CVS + ((size_t)bd * 3 + (ts - (DEC_SEQ - 3))) * 1024 + c] = v;
            B.smp[(size_t)typ * (R_SAMPLE * 1024) + (size_t)r * 1024 + c] = (bf16)f2bf(typ == 0 ? v * QSCALE : v);
        } else if (typ >= 1 && typ <= 4) {
            const int t = r - R_SAMPLE; bf16* dst = typ == 1 ? B.Ks : typ == 2 ? B.Vs : typ == 3 ? B.Us : B.VMs; const bf16 hv = (bf16)f2bf(v);
#pragma unroll
            for (int b = 0; b < BATCH; ++b) { const size_t o = ((size_t)b * T + t) * 1024 + c; dst[o] = hv;
                if (typ == 1) B.out[O_KP + o] = v;
                if (typ == 2) B.out[O_VP + o] = v; }
        }
    }
}

__device__ __forceinline__ float bfu(unsigned short h) { return __uint_as_float((unsigned)h << 16); }
__device__ __forceinline__ float sigm(float x) { return 1.0f / (1.0f + __expf(-x)); }
__device__ __forceinline__ float logsig(float x) { return fminf(x, 0.f) - log1pf(expf(-fabsf(x))); }
__device__ __forceinline__ v4u conv_item(const void* const (&rows)[4], const bool (&isf)[4], const float* cw, const float* cb, int c0) {
    float acc[8];
    { const f32x4 b0 = *(const GAS f32x4*)(cb + c0), b1 = *(const GAS f32x4*)(cb + c0 + 4); acc[0] = b0[0]; acc[1] = b0[1]; acc[2] = b0[2]; acc[3] = b0[3]; acc[4] = b1[0]; acc[5] = b1[1]; acc[6] = b1[2]; acc[7] = b1[3]; }
#pragma unroll
    for (int j = 0; j < 4; ++j) if (rows[j]) { float u[8];
        if (isf[j]) { const f32x4 a = *(const GAS f32x4*)rows[j], b = *((const GAS f32x4*)rows[j] + 1); u[0] = a[0]; u[1] = a[1]; u[2] = a[2]; u[3] = a[3]; u[4] = b[0]; u[5] = b[1]; u[6] = b[2]; u[7] = b[3]; }
        else { const v4u a = *(const GAS v4u*)rows[j]; u[0] = __uint_as_float(a.x << 16); u[1] = __uint_as_float(a.x & 0xffff0000u); u[2] = __uint_as_float(a.y << 16); u[3] = __uint_as_float(a.y & 0xffff0000u);
            u[4] = __uint_as_float(a.z << 16); u[5] = __uint_as_float(a.z & 0xffff0000u); u[6] = __uint_as_float(a.w << 16); u[7] = __uint_as_float(a.w & 0xffff0000u); }
        const f32x4 w0 = *(const GAS f32x4*)(cw + j * MLSTM_WIDTH + c0), w1 = *(const GAS f32x4*)(cw + j * MLSTM_WIDTH + c0 + 4);
        acc[0] += u[0] * w0[0]; acc[1] += u[1] * w0[1]; acc[2] += u[2] * w0[2]; acc[3] += u[3] * w0[3]; acc[4] += u[4] * w1[0]; acc[5] += u[5] * w1[1]; acc[6] += u[6] * w1[2]; acc[7] += u[7] * w1[3]; }
#pragma unroll
    for (int i = 0; i < 8; ++i) acc[i] = acc[i] * sigm(acc[i]);
    v4u o; o.x = pk2(acc[0], acc[1]); o.y = pk2(acc[2], acc[3]); o.z = pk2(acc[4], acc[5]); o.w = pk2(acc[6], acc[7]); return o;
}
__device__ __forceinline__ void conv_seg8(const bf16* Us, bf16* dst, const float* cw, const float* cb, int row0, int t0, int c0) {
    v4u uin[11];
#pragma unroll
    for (int k = 0; k < 11; ++k) uin[k] = (t0 - 3 + k >= 0) ? *(const GAS v4u*)(Us + (size_t)(row0 - 3 + k) * 1024 + c0) : (v4u){0u, 0u, 0u, 0u};
    float w[4][8], bias[8];
#pragma unroll
    for (int j = 0; j < 4; ++j) { const f32x4 w0 = *(const GAS f32x4*)(cw + j * MLSTM_WIDTH + c0), w1 = *(const GAS f32x4*)(cw + j * MLSTM_WIDTH + c0 + 4);
        w[j][0] = w0[0]; w[j][1] = w0[1]; w[j][2] = w0[2]; w[j][3] = w0[3]; w[j][4] = w1[0]; w[j][5] = w1[1]; w[j][6] = w1[2]; w[j][7] = w1[3]; }
    { const f32x4 b0 = *(const GAS f32x4*)(cb + c0), b1 = *(const GAS f32x4*)(cb + c0 + 4); bias[0] = b0[0]; bias[1] = b0[1]; bias[2] = b0[2]; bias[3] = b0[3]; bias[4] = b1[0]; bias[5] = b1[1]; bias[6] = b1[2]; bias[7] = b1[3]; }
#pragma unroll
    for (int k = 0; k < 8; ++k) { float acc[8];
#pragma unroll
        for (int i = 0; i < 8; ++i) acc[i] = bias[i];
#pragma unroll
        for (int j = 0; j < 4; ++j) { const v4u u = uin[k + j]; const unsigned uw[4] = {u.x, u.y, u.z, u.w};
#pragma unroll
            for (int i = 0; i < 4; ++i) { acc[2 * i] += __uint_as_float(uw[i] << 16) * w[j][2 * i]; acc[2 * i + 1] += __uint_as_float(uw[i] & 0xffff0000u) * w[j][2 * i + 1]; } }
#pragma unroll
        for (int i = 0; i < 8; ++i) acc[i] = acc[i] * sigm(acc[i]);
        v4u o; o.x = pk2(acc[0], acc[1]); o.y = pk2(acc[2], acc[3]); o.z = pk2(acc[4], acc[5]); o.w = pk2(acc[6], acc[7]);
        *(GAS v4u*)(dst + (size_t)k * 1024 + c0) = o; }
}
__device__ __forceinline__ void handoff_publish(gu32* ctr, int tid) {
    asm volatile("s_waitcnt vmcnt(0)" ::: "memory"); __syncthreads();
    if (tid == 0) __hip_atomic_fetch_add(ctr, 1u, __ATOMIC_RELEASE, __HIP_MEMORY_SCOPE_AGENT);
}
__device__ __forceinline__ void handoff_publish_wt(gu32* ctr, int tid) {
    asm volatile("s_waitcnt vmcnt(0)" ::: "memory"); __syncthreads();
    if (tid == 0) __hip_atomic_fetch_add(ctr, 1u, __ATOMIC_RELAXED, __HIP_MEMORY_SCOPE_AGENT);
}
__device__ __forceinline__ void handoff_wait(gu32* ctr, unsigned need, int tid) {
    if (tid == 0) { int spins = 0; while (__hip_atomic_load(ctr, __ATOMIC_RELAXED, __HIP_MEMORY_SCOPE_AGENT) < need && ++spins < (1 << 20)) __builtin_amdgcn_s_sleep(16);
        __builtin_amdgcn_fence(__ATOMIC_ACQUIRE, "agent"); }
    __syncthreads();
}
__device__ __forceinline__ void gate_scan(const float* GATES, const float* gate_bias, float* SCAN, float* out_m, int bh, int lane) {
    constexpr float LOG2E = 1.4426950408889634f; constexpr int SEG = (T + 63) / 64;
    const int b = bh / N_HEADS_M, h = bh % N_HEADS_M; const float bi = gate_bias[h], bfg = gate_bias[N_HEADS_M + h];
    const int t0 = lane * SEG, t1 = t0 + SEG < T ? t0 + SEG : T; const float* g = GATES + (size_t)b * T * 8;
    float a = 0.f, c = -INFINITY; float gi_[SEG], gf_[SEG];
#pragma unroll
    for (int k = 0; k < SEG; ++k) { const int t = t0 + k < T ? t0 + k : T - 1; gi_[k] = g[t * 8 + h]; gf_[k] = g[t * 8 + 4 + h]; }
#pragma unroll
    for (int k = 0; k < SEG; ++k) { const float ig = gi_[k] + bi, lf = logsig(gf_[k] + bfg); gi_[k] = ig; gf_[k] = lf; if (t0 + k < t1) { a += lf; c = fmaxf(c + lf, ig); } }
    float ia = a, ic = c;
#pragma unroll
    for (int o = 1; o < 64; o <<= 1) { const float pa = __shfl_up(ia, o), pc = __shfl_up(ic, o); if (lane >= o) { ic = fmaxf(pc + ia, ic); ia = pa + ia; } }
    float ea = __shfl_up(ia, 1), ec = __shfl_up(ic, 1); if (lane == 0) { ea = 0.f; ec = -INFINITY; }
    float B = ea, m = fmaxf(ea, ec);
    float* A2 = SCAN + (size_t)bh * T; float* C2 = SCAN + SCANN + (size_t)bh * T; float* MT = SCAN + 2 * SCANN + (size_t)bh * T;
#pragma unroll
    for (int k = 0; k < SEG; ++k) { const int t = t0 + k; if (t < t1) { const float ig = gi_[k], lf = gf_[k]; B += lf; m = fmaxf(lf + m, ig);
        A2[t] = (B - m) * LOG2E; C2[t] = (ig - B) * LOG2E; MT[t] = m;
        if (t == T - 1) { SCAN[3 * SCANN + bh] = (B - m) * LOG2E; out_m[bh] = m; } } }
}
struct QkTail { bf16 *MQs, *MKs, *smp; };
__device__ __forceinline__ void qk_tail_epi(const QkTail& B, const LAS float* z, int gi, int wave, int lane) {
    const int head = gi >> 3, isk = (gi >> 2) & 1, c = head * 256 + (gi & 3) * 64 + lane;
    for (int r = wave; r < 48; r += NWAVES) { const bf16 hv = (bf16)f2bf(z[r * 68 + lane]);
        if (r < R_SAMPLE) B.smp[(size_t)(6 + isk) * (R_SAMPLE * 1024) + (size_t)r * 1024 + c] = hv;
        else { bf16* dst = B.MQs + (size_t)isk * ((WS_MKS - WS_MQS) / 2);
#pragma unroll
            for (int b = 0; b < BATCH; ++b) dst[((size_t)b * T + (r - R_SAMPLE)) * 1024 + c] = hv; } }
}

typedef const Args __attribute__((address_space(4)))* KArgs;
#define PHASE_ARGS KArgs ap = (KArgs)__builtin_amdgcn_kernarg_segment_ptr(); asm volatile("" : "+s"(ap))
__global__ void __launch_bounds__(NTHREADS, 2) mega_fwd(Args args) {
    extern __shared__ __attribute__((aligned(16))) unsigned char lds[];
    Frame F; F.lds = (LAS unsigned char*)lds; F.MISC = (volatile LAS unsigned*)(F.lds + MISC_OFF);
    F.tid = threadIdx.x; F.lane = F.tid & 63; F.wave = __builtin_amdgcn_readfirstlane(F.tid >> 6);
    F.G = gridDim.x; { const int bx = blockIdx.x; F.vcu = (F.G % 8 == 0) ? (bx % 8) * (F.G / 8) + bx / 8 : bx; }
    unsigned char* ws = args.fws;
    gu32* ctl = (gu32*)(ws + WS_CTL);
    for (int u = F.tid; u < (LDS_BYTES - LDSCTL_OFF) / 4; u += NTHREADS) ((LAS unsigned*)(F.lds + LDSCTL_OFF))[u] = 0u;
    __syncthreads();
    XcdBarrier bar = xcd_barrier_post((unsigned*)(ctl + CW_BAR) + args.li * XCD_BAR_WORDS, F.MISC + 8);
    const int lo = args.ph_lo, hi = args.ph_hi;
#ifndef PH_MASK
#define PH_MASK 0xffff
#endif
#define IN(k) (((PH_MASK >> (k)) & 1) && lo <= (k) && (k) < hi)
#define BOTH(k) (IN(k) && IN((k) + 1))
#ifndef DUP_MASK
#define DUP_MASK 0
#endif
#define REP(k) _Pragma("unroll") for (int rep_ = 0; rep_ < (((DUP_MASK >> (k)) & 1) ? 2 : 1); ++rep_)
    bf16* Wout_t = (bf16*)(ws + WS_WOUT); bf16* Wup_t = (bf16*)(ws + WS_WUP); bf16* Wdown_t = (bf16*)(ws + WS_WDOWN);
    bf16* Win_t = (bf16*)(ws + WS_WIN); bf16* XNb = (bf16*)(ws + WS_XN); bf16* XNs = (bf16*)(ws + WS_XNS); float* GATES = (float*)(ws + WS_GATES);
    bf16 *Qs = (bf16*)(ws + WS_QS), *Ks = (bf16*)(ws + WS_KS), *Vs = (bf16*)(ws + WS_VS), *Us = (bf16*)(ws + WS_US), *VMs = (bf16*)(ws + WS_VMS), *OGs = (bf16*)(ws + WS_OGS);
    bf16 *UAs = (bf16*)(ws + WS_UAS), *MQs = (bf16*)(ws + WS_MQS), *MKs = (bf16*)(ws + WS_MKS), *SMP = (bf16*)(ws + WS_SMP), *UAt = (bf16*)(ws + WS_UAT), *Wqk_t = (bf16*)(ws + WS_WQK);
    float* SCAN = (float*)(ws + WS_SCAN); float* PO = (float*)(ws + WS_PO); float* PML = (float*)(ws + WS_PML); bf16* AOs = (bf16*)(ws + WS_AOS);
    float* X1s = (float*)(ws + WS_X1S); bf16* XN2s = (bf16*)(ws + WS_XN2S); float* SSQs = (float*)(ws + WS_SSQS); bf16* Hs = (bf16*)(ws + WS_HS);
    bf16* AO = (bf16*)(ws + WS_AO); bf16* XN2 = (bf16*)(ws + WS_XN2); bf16* H = (bf16*)(ws + WS_H); float* SSQ = (float*)(ws + WS_SSQ);
    float* X1 = args.out + O_Y;

    if (IN(0)) REP(0) { PHASE_ARGS;
        LAS float* scr = (LAS float*)(F.lds + RING_OFF + F.wave * 16384);
        const int gw = F.vcu * NWAVES + F.wave, NGW = F.G * NWAVES;
        constexpr int I_I = (D_MODEL / 64) * (6144 / 32), I_O = (D_MODEL / 64) * (D_MODEL / 32), I_U = (D_MODEL / 64) * (D_FF / 32), I_D = (D_FF / 64) * (D_MODEL / 32), I_M = (HEAD_DIM_M / 64) * (HEAD_DIM_M / 32);
        static_assert(HEAD_DIM_M == 256, "k scale 1/16");
        for (int it = gw; it < I_I + 2 * N_HEADS_M * I_M; it += NGW) {
            int r = it;
            if (r < I_I) { p0_transpose_item(ap->w_in, PROJ_WIDTH, D_MODEL, 6144, Win_t, scr, r, F.lane); continue; } r -= I_I;
            { const int hm = r / I_M, ri = r % I_M, hd = hm >> 1, isk = hm & 1;
              p0_transpose_item((isk ? ap->w_km : ap->w_qm) + (size_t)hd * HEAD_DIM_M * HEAD_DIM_M, HEAD_DIM_M, HEAD_DIM_M, HEAD_DIM_M, Wqk_t + ((size_t)hd * 2 + isk) * HEAD_DIM_M * HEAD_DIM_M, scr, ri, F.lane, isk ? 0.0625f : 1.0f); }
        }
        __syncthreads();
        LAS float* WgT = (LAS float*)(F.lds + RING_OFF);
        { f32x4 ga[D_MODEL / NTHREADS], gb[D_MODEL / NTHREADS];
#pragma unroll
          for (int j = 0; j < D_MODEL / NTHREADS; ++j) { const float* gp = ap->w_in + (size_t)(F.tid + NTHREADS * j) * PROJ_WIDTH + 6144; ga[j] = *(const GAS f32x4*)gp; gb[j] = *(const GAS f32x4*)(gp + 4); }
#pragma unroll
          for (int j = 0; j < D_MODEL / NTHREADS; ++j) { const int k = F.tid + NTHREADS * j;
#pragma unroll
              for (int g = 0; g < 4; ++g) { WgT[g * D_MODEL + k] = ga[j][g]; WgT[(4 + g) * D_MODEL + k] = gb[j][g]; } } }
        __syncthreads();
        { f32x4 nmix[8];
#pragma unroll
          for (int j = 0; j < 8; ++j) nmix[j] = *((const GAS f32x4*)ap->norm_mix + F.lane + 64 * j);
          for (int r = gw; r < R_ALL; r += NGW) p0_row(ap->x_prompt, ap->x_sample, ap->meta, nmix, r, XNb, XNs, GATES, WgT, F.lane); }
        for (int i = gw * 64 + F.lane; i < 16 * D_MODEL / 8; i += NGW * 64) *(GAS v4u*)(XNs + (size_t)48 * D_MODEL + (size_t)i * 8) = (v4u){0u, 0u, 0u, 0u};
        __syncthreads();
        if (BOTH(0)) xcd_barrier(bar, F.wave);
    }
    if (IN(1)) REP(1) { PHASE_ARGS; F.lane = lane_now(); F.tid = F.wave * 64 + F.lane;
        { LAS float* red = (LAS float*)(F.lds + RING_OFF); LAS float* z = red + 2 * 4 * 3 * 256;
          const TailBufs TB{Ks, Vs, Us, VMs, (bf16*)(ws + WS_SMP), ap->out, ap->q_norm, ap->k_norm};
          for (int gi = (int)blockIdx.x; gi < 6144 / 64; gi += F.G) { skinny_gemm<3, 4, 2>(XNs, D_MODEL, Win_t, D_MODEL, gi * 64, D_MODEL, red, z, F.tid, F.wave, F.lane); inproj_tail_epi(TB, z, gi, F.wave, F.lane); __syncthreads(); } }
        xcd_barrier(bar, F.wave);
        pg8::Gemm g{XNb, Win_t, R_PROMPT, 6144, D_MODEL, D_MODEL, D_MODEL, 0, 0, 0, 0};
        pg8::EpiInProj E{Qs, Ks, Vs, Us, VMs, OGs, ap->out + O_KP, ap->out + O_VP, ap->out + O_CVP, ap->q_norm, ap->k_norm, QSCALE, T, SEQ, N_META};
        const int bx_ = (int)blockIdx.x, q_ = bx_ >> 3, role = ((q_ & 3) == 3) ? 1 : 0, ridx = role ? (q_ >> 2) * 8 + (bx_ & 7) : ((q_ >> 2) * 3 + (q_ & 3)) * 8 + (bx_ & 7);
        if (role == 0) { pg8::RangeOrder S; S.b.init(R_PROMPT, 6144, F.G * 3 / 4, ridx); S.lo = 0; S.hi = 1 << 20;
            pg8::gemm_phase<pg8::EpiInProj, pg8::RangeOrder, true, true>(F.lds + RING_OFF, g, S, E, F.wave); }
        else { const dec::DArgs DA{ap->cache_k, ap->cache_v, ap->page_table, SMP, PO, PML};
            for (int u = 2 * ridx; u < 2 * ridx + 2; ++u) { dec::decode_unit(DA, F.lds + RING_OFF, u / dec::NSPLIT, u % dec::NSPLIT, F.wave, F.lane); handoff_publish_wt(ctl + CW_DECC, F.tid); } }
        if (BOTH(1)) xcd_barrier(bar, F.wave);
    }
    if (IN(4)) REP(4) { PHASE_ARGS; F.lane = lane_now(); F.tid = F.wave * 64 + F.lane;
        float lam; { const float* lq = ap->lambda_qk; float a = lq[F.lane] * lq[64 + F.lane], c = lq[128 + F.lane] * lq[192 + F.lane]; a = wave_sum(a); c = wave_sum(c); lam = expf(a) - expf(c) + LAM_INIT; lam = __uint_as_float((unsigned)__builtin_amdgcn_readfirstlane((int)__float_as_uint(lam))); }
        constexpr int NA = BATCH * N_HEADS_A, NM = BATCH * N_HEADS_M, NXQ = 8, LA = NA / NXQ, LM = NM / NXQ, NDQ = DEC_BATCH * dec::NSPLIT / 2, LD = NDQ / NXQ / 8, LBIG = 8 * (LA + LM + LD) + 8 * (LA + LM), LCEND = LM * 4, LSM = DEC_BATCH * N_HEADS_M / NXQ, LCONV = 64, CONV_ITEMS = 36, LCOMB = DEC_BATCH * N_HEADS_A * DEC_SEQ / (NXQ * NWAVES),
            LQK = (R_PROMPT / 256) * N_HEADS_M / NXQ, LQT = 2 * MLSTM_WIDTH / 64 / NXQ, LSC = NM / NXQ, LPRE = LQK + LQT + LSC, NPROD = NXQ * LPRE, NLOC = LPRE + LBIG + LCEND + LSM + LCONV + LCOMB;
        static_assert((R_PROMPT / 256) * N_HEADS_M % NXQ == 0 && (2 * MLSTM_WIDTH / 64) % NXQ == 0, "producer lists");
        static_assert(NDQ == NXQ * 8 * LD && DEC_BATCH * dec::NSPLIT == 256, "decode units: 128 in the in-projection phase, 128 on the first eight levels of the queue");
        static_assert(NA % NXQ == 0 && NM % NXQ == 0 && (DEC_BATCH * N_HEADS_M) % NXQ == 0, "XCD-local lists");
        static_assert(NPROD <= 256, "one producer grab per workgroup covers the list");
        int xq = (int)(bar.x % NXQ), tries = 0, pend = -1; bool first = true;
        for (;;) {
            int g_, xu, idx0; bool isprod = false;
            __syncthreads();
            if (pend >= 0) { g_ = pend; pend = -1; }
            else { if (F.tid == 0) { unsigned a_ = 0u; if (first) a_ = __hip_atomic_fetch_add(ctl + CW_PQ + 16 * rep_, 1u, RLX_AGENT);
                                     const unsigned b_ = __hip_atomic_fetch_add(ctl + CW_DECQ + 64 * (1 + xq + 16 * rep_), 1u, RLX_AGENT); F.MISC[17] = a_; F.MISC[16] = b_; }
                   __syncthreads(); g_ = (int)F.MISC[16];
                   if (first) { first = false; const int p_ = (int)F.MISC[17]; if (p_ < NPROD) { isprod = true; pend = g_; xu = p_ / LPRE; idx0 = p_ % LPRE; } } }
            if (!isprod) { if (g_ >= NLOC - LPRE) { if (++tries >= NXQ) break; xq = (xq + 1) % NXQ; continue; } xu = xq; idx0 = g_ + LPRE; }
            F.lane = lane_now(); F.tid = F.wave * 64 + F.lane;
            unsigned char* w2 = ws; asm volatile("" : "+s"(w2));
            const int idx = idx0 - LPRE;
            if (idx0 < LQK) {
                const int pu = xu * LQK + idx0, pm = pu >> 2, h = pu & 3, srow0 = pm * 256 + (pm / (SEQ / 256) + 1) * N_META; bf16* uas = (bf16*)(w2 + WS_UAS);
                for (int it = F.tid; it < 32 * 32; it += NTHREADS) { const int row0 = srow0 + (it >> 5) * 8, c0 = h * HEAD_DIM_M + (it & 31) * 8;
                    conv_seg8((const bf16*)(w2 + WS_US), uas + (size_t)row0 * 1024, ap->conv_w, ap->conv_b, row0, row0 % T, c0); }
                asm volatile("s_waitcnt vmcnt(0)" ::: "memory"); __syncthreads();
                const pg8::Gemm g{uas, (bf16*)(w2 + WS_WQK), R_PROMPT, 2 * MLSTM_WIDTH, HEAD_DIM_M, MLSTM_WIDTH, HEAD_DIM_M, SEQ / 256, N_META, 2, HEAD_DIM_M}; const pg8::PairOrder S{pm, 2 * h};
                const pg8::EpiQKwt E{(bf16*)(w2 + WS_MQS), (long long)((WS_MKS - WS_MQS) / 2), T, SEQ, N_META, (int)SEQB};
                pg8::gemm_phase<pg8::EpiQKwt, pg8::PairOrder, true, true>(F.lds + RING_OFF, g, S, E, F.wave);
                handoff_publish_wt(ctl + CW_QKC, F.tid); }
            else if (idx0 < LQK + LQT) {
                const int gi = xu * LQT + (idx0 - LQK), hh = gi >> 3; bf16* uat = (bf16*)(w2 + WS_UAT); const bf16* smp = (const bf16*)(w2 + WS_SMP);
                for (int it = F.tid; it < 64 * 32; it += NTHREADS) { const int row = it >> 5, c0 = hh * HEAD_DIM_M + (it & 31) * 8;
                    if (row < R_SAMPLE) { const int bd = row / DEC_SEQ, ts = row % DEC_SEQ; const void* rows[4]; bool isf[4] = {false, false, false, false};
#pragma unroll
                        for (int j = 0; j < 4; ++j) { const int tt = ts - 3 + j; isf[j] = tt < 0;
                            rows[j] = tt >= 0 ? (const void*)(smp + 3 * (size_t)(R_SAMPLE * 1024) + (size_t)(bd * DEC_SEQ + tt) * 1024 + c0) : (const void*)(ap->state_conv + ((size_t)bd * 3 + (tt + 3)) * MLSTM_WIDTH + c0); }
                        *(GAS v4u*)(uat + (size_t)row * 1024 + c0) = conv_item(rows, isf, ap->conv_w, ap->conv_b, c0); }
                    else if (row < R_SAMPLE + N_META / 8) { const int r0 = (row - R_SAMPLE) * 8; conv_seg8((const bf16*)(w2 + WS_US), uat + (size_t)(R_SAMPLE + r0) * 1024, ap->conv_w, ap->conv_b, r0, r0, c0); }
                    else if (row >= 48) *(GAS v4u*)(uat + (size_t)row * 1024 + c0) = (v4u){0u, 0u, 0u, 0u}; }
                asm volatile("s_waitcnt vmcnt(0)" ::: "memory"); __syncthreads();
                LAS float* red = (LAS float*)(F.lds + RING_OFF); LAS float* z = red + 2 * 4 * 3 * 256; const QkTail QT{(bf16*)(w2 + WS_MQS), (bf16*)(w2 + WS_MKS), (bf16*)(w2 + WS_SMP)};
                skinny_gemm<3, 4, 2>(uat + hh * HEAD_DIM_M, MLSTM_WIDTH, (bf16*)(w2 + WS_WQK), HEAD_DIM_M, gi * 64, HEAD_DIM_M, red, z, F.tid, F.wave, F.lane); qk_tail_epi(QT, z, gi, F.wave, F.lane);
                handoff_publish(ctl + CW_QKC, F.tid); }
            else if (idx0 < LPRE) {
                const int bh = xu * LSC + (idx0 - LQK - LQT);
                if (F.wave == 0) gate_scan((float*)(w2 + WS_GATES), ap->gate_bias, (float*)(w2 + WS_SCAN), ap->out + O_MP, bh, F.lane);
                handoff_publish(ctl + CW_QKC, F.tid); }
            else if (idx < LBIG) { constexpr int L8 = 8 * (LA + LM + LD); const int lev = idx < L8 ? idx / (LA + LM + LD) : 8 + (idx - L8) / (LA + LM), w = idx < L8 ? idx % (LA + LM + LD) : (idx - L8) % (LA + LM), jb = 15 - lev;
                if (w >= LA + LM) {
                    const int u = NDQ + (xu * 8 + lev) * LD + (w - LA - LM); const dec::DArgs DA{ap->cache_k, ap->cache_v, ap->page_table, (bf16*)(w2 + WS_SMP), (float*)(w2 + WS_PO), (float*)(w2 + WS_PML)};
                    dec::decode_unit(DA, F.lds + RING_OFF, u / dec::NSPLIT, u % dec::NSPLIT, F.wave, F.lane);
                    handoff_publish_wt(ctl + CW_DECC, F.tid); }
                else
                if (w < LA) { const int bh = xu * LA + w; const att::AttnArgs AA{(bf16*)(w2 + WS_QS), (bf16*)(w2 + WS_KS), (bf16*)(w2 + WS_VS), (bf16*)(w2 + WS_AO), ap->attn_out_norm, lam, 1.0f - LAM_INIT};
                    att::attn_unit(AA, F.lds + RING_OFF, bh / N_HEADS_A, bh % N_HEADS_A, jb, F.tid, F.wave, F.lane); }
                else { handoff_wait(ctl + CW_QKC, NPROD, F.tid); const int bh = xu * LM + (w - LA); float* sc = (float*)(w2 + WS_SCAN); const mls::MArgs MA{(bf16*)(w2 + WS_MQS), (bf16*)(w2 + WS_MKS), (bf16*)(w2 + WS_VMS), (bf16*)(w2 + WS_OGS), (bf16*)(w2 + WS_AO), sc, sc + SCANN, sc + 2 * SCANN, ap->mlstm_out_norm};
                    mls::mlstm_unit(MA, F.lds, bh / N_HEADS_M, bh % N_HEADS_M, jb, F.tid, F.wave, F.lane); } }
            else if (idx < LBIG + LCEND) { handoff_wait(ctl + CW_QKC, NPROD, F.tid); const int i = idx - LBIG, bh = xu * LM + (i >> 2); float* sc = (float*)(w2 + WS_SCAN);
                const mls::MArgs MA{(bf16*)(w2 + WS_MQS), (bf16*)(w2 + WS_MKS), (bf16*)(w2 + WS_VMS), (bf16*)(w2 + WS_OGS), (bf16*)(w2 + WS_AO), sc, sc + SCANN, sc + 2 * SCANN, ap->mlstm_out_norm};
                mls::cend_unit(MA, sc + 3 * SCANN, ap->out + O_CP, ap->out + O_NP, F.lds, bh / N_HEADS_M, bh % N_HEADS_M, i & 3, F.tid, F.wave, F.lane); }
            else if (idx >= LBIG + LCEND + LSM + LCONV) {
                handoff_wait(ctl + CW_DECC, DEC_BATCH * dec::NSPLIT, F.tid); const int lc_ = lane_now();
                const int i = (xu * LCOMB + (idx - LBIG - LCEND - LSM - LCONV)) * NWAVES + F.wave;
                const dec::CArgs CA{(float*)(w2 + WS_PO), (float*)(w2 + WS_PML), (bf16*)(w2 + WS_SMP), (bf16*)(w2 + WS_AOS), ap->attn_out_norm, lam, 1.0f - LAM_INIT};
                dec::decode_combine(CA, i / (N_HEADS_A * DEC_SEQ), (i / DEC_SEQ) % N_HEADS_A, i % DEC_SEQ, lc_); }
            else if (idx >= LBIG + LCEND + LSM) {
                constexpr int I_O = (D_MODEL / 64) * (D_MODEL / 32), I_U = (D_MODEL / 64) * (D_FF / 32), I_D = (D_FF / 64) * (D_MODEL / 32);
                static_assert(I_O + I_U + I_D == NXQ * LCONV * CONV_ITEMS, "conversion units");
                const int ln_ = lane_now();
                LAS float* scr = (LAS float*)(F.lds + RING_OFF + F.wave * 16384); const int cu = xu * LCONV + (idx - LBIG - LCEND - LSM);
                for (int it = cu * CONV_ITEMS + F.wave; it < (cu + 1) * CONV_ITEMS; it += NWAVES) { int r = it;
                    if (r < I_O) { p0_transpose_item(ap->w_out, D_MODEL, D_MODEL, D_MODEL, (bf16*)(w2 + WS_WOUT), scr, r, ln_); continue; } r -= I_O;
                    if (r < I_U) { p0_transpose_item(ap->w_up, D_FF, D_MODEL, D_FF, (bf16*)(w2 + WS_WUP), scr, r, ln_); continue; } r -= I_U;
                    p0_transpose_item(ap->w_down, D_MODEL, D_FF, D_MODEL, (bf16*)(w2 + WS_WDOWN), scr, r, ln_); } }
            else { handoff_wait(ctl + CW_QKC, NPROD, F.tid); const int i = xu * LSM + (idx - LBIG - LCEND); const dec::SArgs SA{ap->state_C, ap->state_n, ap->state_m, (float*)(w2 + WS_GATES), ap->gate_bias, ap->mlstm_out_norm, (bf16*)(w2 + WS_SMP), (bf16*)(w2 + WS_AOS), ap->out + O_CS, ap->out + O_NS, ap->out + O_MS};
                dec::sample_mlstm_unit(SA, (LAS float*)(F.lds + RING_OFF), i / N_HEADS_M, i % N_HEADS_M, F.tid, F.wave, F.lane); }
        }
        if (BOTH(4)) xcd_barrier(bar, F.wave);
    }
    if (IN(5)) REP(5) { PHASE_ARGS; F.lane = lane_now(); F.tid = F.wave * 64 + F.lane;
        pg8::Gemm g{AO, Wout_t, R_PROMPT, D_MODEL, D_MODEL, D_MODEL, D_MODEL, 0, 0, 0, 0}; pg8::StaticOrder S; S.init(R_PROMPT, D_MODEL, F.G, (int)blockIdx.x);
        pg8::EpiOutProj E{ap->x_prompt, X1, XN2, ap->norm_ffn, SSQ, D_MODEL};
        pg8::gemm_phase<pg8::EpiOutProj, pg8::StaticOrder, false, true>(F.lds + RING_OFF, g, S, E, F.wave);
        {
            LAS float* red = (LAS float*)(F.lds + RING_OFF); LAS float* z = red + 8 * 1 * 2 * 256;
            for (int nt = (int)blockIdx.x; nt < D_MODEL / 16; nt += F.G) { skinny_gemm<2, 1, 8>(AOs, D_MODEL, Wout_t, D_MODEL, nt * 16, D_MODEL, red, z, F.tid, F.wave, F.lane);
                const int row = F.tid >> 4, col = nt * 16 + (F.tid & 15); const float x1 = ap->x_sample[(size_t)row * D_MODEL + col] + z[row * 20 + (F.tid & 15)];
                X1s[(size_t)row * D_MODEL + col] = x1; XN2s[(size_t)row * D_MODEL + col] = (bf16)f2bf(x1 * ap->norm_ffn[col]);
                const float ss = dec::row16_sum(x1 * x1); if ((F.tid & 15) == 0) SSQs[row * 128 + nt] = ss;
                __syncthreads(); } }
        if (BOTH(5)) xcd_barrier(bar, F.wave);
    }
    if (IN(6)) REP(6) { PHASE_ARGS; F.lane = lane_now(); F.tid = F.wave * 64 + F.lane;
        pg8::Gemm g{XN2, Wup_t, R_PROMPT, D_FF, D_MODEL, D_MODEL, D_MODEL, 0, 0, 0, 0}; pg8::StaticOrder S; S.init(R_PROMPT, D_FF, F.G, (int)blockIdx.x);
        pg8::EpiUp E{H, D_FF, SSQ, 1.0f / (float)D_MODEL};
        pg8::gemm_phase<pg8::EpiUp, pg8::StaticOrder, true, true>(F.lds + RING_OFF, g, S, E, F.wave);
        {
            LAS float* red = (LAS float*)(F.lds + RING_OFF); LAS float* z = red + 4 * 2 * 2 * 256;
            for (int u = (int)blockIdx.x; u < D_FF / 32; u += F.G) { skinny_gemm<2, 2, 4>(XN2s, D_MODEL, Wup_t, D_MODEL, u * 32, D_MODEL, red, z, F.tid, F.wave, F.lane);
                const int row = F.tid >> 4, part = F.tid & 15; float ps = 0.f;
#pragma unroll
                for (int k = 0; k < 8; ++k) ps += SSQs[row * 128 + part * 8 + k];
                const float rstd = 1.0f / sqrtf(dec::row16_sum(ps) * (1.0f / D_MODEL) + EPS);
#pragma unroll
                for (int k = 0; k < 2; ++k) { const int cl = part * 2 + k; float v = z[row * 36 + cl] * rstd; v = v > 0.f ? v * v : 0.f; Hs[(size_t)row * D_FF + u * 32 + cl] = (bf16)f2bf(v); }
                __syncthreads(); } }
        if (BOTH(6)) xcd_barrier(bar, F.wave);
    }
    if (IN(7)) { PHASE_ARGS; F.lane = lane_now(); F.tid = F.wave * 64 + F.lane;
        pg8::Gemm g{H, Wdown_t, R_PROMPT, D_MODEL, D_FF, D_FF, D_FF, 0, 0, 0, 0}; pg8::StaticOrder S; S.init(R_PROMPT, D_MODEL, F.G, (int)blockIdx.x);
        pg8::EpiDown E{X1, X1, D_MODEL};
        pg8::gemm_phase<pg8::EpiDown, pg8::StaticOrder, false, true>(F.lds + RING_OFF, g, S, E, F.wave);
        {
            LAS float* red = (LAS float*)(F.lds + RING_OFF); LAS float* z = red + 8 * 1 * 2 * 256;
            for (int nt = (int)blockIdx.x; nt < D_MODEL / 16; nt += F.G) { skinny_gemm<2, 1, 8>(Hs, D_FF, Wdown_t, D_FF, nt * 16, D_FF, red, z, F.tid, F.wave, F.lane);
                const int row = F.tid >> 4, col = nt * 16 + (F.tid & 15); ap->out[O_YS + (size_t)row * D_MODEL + col] = X1s[(size_t)row * D_MODEL + col] + z[row * 20 + (F.tid & 15)];
                __syncthreads(); }
        }
    }
#undef IN
#undef BOTH
}
}

extern "C" void kernel_launch(void* const* d_in, const int* in_sizes, int n_in, void* d_out, int out_size, void* d_ws, size_t ws_size, hipStream_t stream) {
    static int ready = 0;
    if (!ready) {
        if (ws_size < mk::FAST_BASE + mk::WS_FAST_END || out_size != (int)cfg::O_END || n_in != 26) { fprintf(stderr, "kernel_launch: unexpected sizes (ws %zu, out %d, n_in %d)\n", ws_size, out_size, n_in); ready = -1; return; }
        if (hipFuncSetAttribute((const void*)mk::mega_fwd, hipFuncAttributeMaxDynamicSharedMemorySize, mk::LDS_BYTES) != hipSuccess) { fprintf(stderr, "kernel_launch: hipFuncSetAttribute failed\n"); ready = -1; return; }
        ready = 1;
    }
    if (ready < 0) return;
    unsigned char* fws = (unsigned char*)d_ws + mk::FAST_BASE;
    (void)hipMemsetAsync(fws + mk::WS_CTL, 0, mk::CTL_ZERO_BYTES, stream);
    auto F32 = [&](int i) { return (const float*)d_in[i]; };
    mk::Args a{}; a.x_prompt = F32(0); a.x_sample = F32(1); a.cache_k = F32(2); a.cache_v = F32(3); a.state_C = F32(4); a.state_n = F32(5); a.state_m = F32(6); a.state_conv = F32(7);
    a.page_table = (const int*)d_in[8]; a.meta = F32(9); a.norm_mix = F32(10); a.w_in = F32(11); a.q_norm = F32(12); a.k_norm = F32(13); a.lambda_qk = F32(14); a.attn_out_norm = F32(15);
    a.conv_w = F32(16); a.conv_b = F32(17); a.w_qm = F32(18); a.w_km = F32(19); a.gate_bias = F32(20); a.mlstm_out_norm = F32(21); a.w_out = F32(22); a.norm_ffn = F32(23); a.w_up = F32(24); a.w_down = F32(25);
    a.ao_f32 = nullptr; a.out = (float*)d_out; a.fws = fws; a.ph_lo = 0; a.ph_hi = 8; a.li = 0;
    hipLaunchKernelGGL(mk::mega_fwd, dim3(mk::GRID), dim3(mk::NTHREADS), mk::LDS_BYTES, stream, a);
}
```
